# Optimizing an MI355X kernel written in HIP

```python
import math
import jax
import jax.numpy as jnp
from jax import lax
import numpy as np

D_MODEL = 4096
BATCH = 4
SEQ = 4096
DEPTH = 1

N_META = 16
CHUNK = 128
RET_HEADS = D_MODEL // 512
RET_DK = 256
RET_DV = 256
SB_HEADS = D_MODEL // 256
SB_DH = 128
RET_WIDTH = RET_HEADS * RET_DV
RET_QK_WIDTH = RET_HEADS * RET_DK
SB_WIDTH = SB_HEADS * SB_DH
MIX_WIDTH = RET_WIDTH + SB_WIDTH
IN_COLS = 2 * RET_QK_WIDTH + 2 * RET_WIDTH + 3 * SB_WIDTH
D_FF = ((8 * D_MODEL // 3 + 255) // 256) * 256
CONV_W = 3
EPS = 1e-6
ROPE_BASE = 10000.0

kernel_name = "hymba_retention_stickbreaking_convffn"


def rms_norm(x, w):
    xf = x.astype(jnp.float32)
    y = xf * lax.rsqrt(jnp.mean(xf * xf, axis=-1, keepdims=True) + EPS)
    return (y * w.astype(jnp.float32)).astype(x.dtype)


def head_rms_norm(y, w):
    b, t, h, d = y.shape
    yf = y.astype(jnp.float32)
    yf = yf * lax.rsqrt(jnp.mean(yf * yf, axis=-1, keepdims=True) + EPS)
    yf = yf * w.astype(jnp.float32).reshape(h, d)
    return yf.reshape(b, t, h * d)


def apply_rotary(x, pos):
    half = x.shape[-1] // 2
    inv = ROPE_BASE ** (-jnp.arange(half, dtype=jnp.float32) / half)
    ang = pos[:, None] * inv[None, :]
    cos = jnp.cos(ang)[None, :, None, :].astype(x.dtype)
    sin = jnp.sin(ang)[None, :, None, :].astype(x.dtype)
    x1, x2 = x[..., :half], x[..., half:]
    return jnp.concatenate([x1 * cos - x2 * sin, x1 * sin + x2 * cos], axis=-1)


def retention_chunkwise(q, k, v):
    b, tp, h, dk = q.shape
    dv = v.shape[-1]
    nc = tp // CHUNK
    log_gamma = jnp.log(1.0 - 2.0 ** (-5.0 - jnp.arange(h, dtype=jnp.float32)))
    idx = jnp.arange(CHUNK, dtype=jnp.float32)
    diff = idx[:, None] - idx[None, :]
    intra_decay = jnp.where(diff[None] >= 0, jnp.exp(jnp.maximum(diff, 0.0)[None] * log_gamma[:, None, None]), 0.0)
    q_decay = jnp.exp((idx[None, :] + 1.0) * log_gamma[:, None])
    k_decay = jnp.exp((CHUNK - 1.0 - idx[None, :]) * log_gamma[:, None])
    chunk_decay = jnp.exp(CHUNK * log_gamma)

    def to_chunks(a):
        return a.reshape(b, nc, CHUNK, h, a.shape[-1]).transpose(1, 0, 3, 2, 4)

    qc, kc, vc = to_chunks(q), to_chunks(k), to_chunks(v)

    def body(state, inp):
        qi, ki, vi = inp
        s = jnp.einsum('bhnd,bhmd->bhnm', qi, ki) * intra_decay[None]
        intra = jnp.einsum('bhnm,bhme->bhne', s, vi)
        cross = jnp.einsum('bhnd,bhde->bhne', qi, state) * q_decay[None, :, :, None]
        new_state = state * chunk_decay[None, :, None, None] + jnp.einsum(
            'bhmd,bhme->bhde', ki * k_decay[None, :, :, None], vi)
        return new_state, intra + cross

    state0 = jnp.zeros((b, h, dk, dv), jnp.float32)
    _, ys = lax.scan(body, state0, (qc, kc, vc))
    return ys.transpose(1, 0, 3, 2, 4).reshape(b, tp, h, dv)


def stick_breaking_attention(q, k, v, key_valid):
    b, tp, h, d = q.shape
    nb = tp // CHUNK
    scale = 1.0 / math.sqrt(d)
    qh = q.transpose(0, 2, 1, 3)
    kh = k.transpose(0, 2, 1, 3)
    vh = v.transpose(0, 2, 1, 3)
    qb = qh.reshape(b, h, nb, CHUNK, d).transpose(2, 0, 1, 3, 4)
    starts = jnp.arange(nb, dtype=jnp.int32) * CHUNK
    key_pos = jnp.arange(tp, dtype=jnp.int32)

    def block(args):
        qblk, start = args
        z = jnp.einsum('bhqd,bhkd->bhqk', qblk, kh).astype(jnp.float32) * scale
        qpos = start + jnp.arange(CHUNK, dtype=jnp.int32)
        mask = (key_pos[None, :] < qpos[:, None]) & key_valid[None, :]
        log_beta = jax.nn.log_sigmoid(z)
        log_keep = jnp.where(mask, jax.nn.log_sigmoid(-z), 0.0)
        rev = lax.cumsum(log_keep, axis=3, reverse=True)
        after = jnp.concatenate([rev[..., 1:], jnp.zeros_like(rev[..., :1])], axis=-1)
        w = jnp.where(mask, jnp.exp(log_beta + after), 0.0)
        return jnp.einsum('bhqk,bhkd->bhqd', w.astype(vh.dtype), vh)

    out = lax.map(block, (qb, starts))
    return out.transpose(1, 0, 3, 2, 4).reshape(b, tp, h, d)


def hybrid_mixer(h, w_in, ret_gn_w, sb_norm_w, w_out):
    b, t, _ = h.shape
    n_pad = CHUNK - N_META
    tp = t + n_pad
    proj = h @ w_in
    proj = jnp.pad(proj, ((0, 0), (n_pad, 0), (0, 0)))
    valid = jnp.arange(tp) >= n_pad
    vmask = valid.astype(proj.dtype)[None, :, None, None]
    pos = (jnp.arange(tp) - n_pad).astype(jnp.float32)

    o = 0
    rq = proj[..., o:o + RET_QK_WIDTH]; o += RET_QK_WIDTH
    rk = proj[..., o:o + RET_QK_WIDTH]; o += RET_QK_WIDTH
    rv = proj[..., o:o + RET_WIDTH]; o += RET_WIDTH
    rg = proj[..., o:o + RET_WIDTH]; o += RET_WIDTH
    sq = proj[..., o:o + SB_WIDTH]; o += SB_WIDTH
    sk = proj[..., o:o + SB_WIDTH]; o += SB_WIDTH
    sv = proj[..., o:o + SB_WIDTH]

    rq = apply_rotary(rq.reshape(b, tp, RET_HEADS, RET_DK), pos) * (RET_DK ** -0.5)
    rk = apply_rotary(rk.reshape(b, tp, RET_HEADS, RET_DK), pos) * vmask
    rv = rv.reshape(b, tp, RET_HEADS, RET_DV) * vmask
    ry = retention_chunkwise(rq, rk, rv)
    ret_out = jax.nn.silu(rg.astype(jnp.float32)) * head_rms_norm(ry, ret_gn_w)

    sq = sq.reshape(b, tp, SB_HEADS, SB_DH)
    sk = sk.reshape(b, tp, SB_HEADS, SB_DH) * vmask
    sv = sv.reshape(b, tp, SB_HEADS, SB_DH) * vmask
    sy = stick_breaking_attention(sq, sk, sv, valid)
    sb_out = head_rms_norm(sy, sb_norm_w)

    mixed = jnp.concatenate([ret_out, sb_out], axis=-1)[:, n_pad:].astype(h.dtype)
    return mixed @ w_out


def conv_ffn(h, w_up, conv_w, conv_b, w_down):
    t = h.shape[1]
    gu = h @ w_up
    gate, up = gu[..., :D_FF], gu[..., D_FF:]
    gp = jnp.pad(gate, ((0, 0), (CONV_W - 1, 0), (0, 0)))
    conv = conv_b[None, None, :]
    for i in range(CONV_W):
        conv = conv + gp[:, i:i + t] * conv_w[i][None, None, :]
    return (jax.nn.silu(conv) * up) @ w_down


def setup_inputs(seed: int = 0) -> dict:
    key = jax.random.key(seed)
    ks = jax.random.split(key, 16)
    f32 = jnp.float32

    def gain(k, n):
        return 1.0 + 0.01 * jax.random.normal(k, (DEPTH, n), f32)

    return {
        "x": jax.random.normal(ks[0], (BATCH, SEQ, D_MODEL), f32),
        "meta_tokens": jax.random.normal(ks[1], (N_META, D_MODEL), f32),
        "attn_pre_norm_w": gain(ks[2], D_MODEL),
        "w_in": jax.random.normal(ks[3], (DEPTH, D_MODEL, IN_COLS), f32) * D_MODEL ** -0.5,
        "ret_gn_w": gain(ks[4], RET_WIDTH),
        "sb_norm_w": gain(ks[5], SB_WIDTH),
        "w_out": jax.random.normal(ks[6], (DEPTH, MIX_WIDTH, D_MODEL), f32) * MIX_WIDTH ** -0.5,
        "attn_post_norm_w": gain(ks[7], D_MODEL),
        "ffn_pre_norm_w": gain(ks[8], D_MODEL),
        "w_up": jax.random.normal(ks[9], (DEPTH, D_MODEL, 2 * D_FF), f32) * D_MODEL ** -0.5,
        "conv_w": jax.random.normal(ks[10], (DEPTH, CONV_W, D_FF), f32) * CONV_W ** -0.5,
        "conv_b": 0.01 * jax.random.normal(ks[11], (DEPTH, D_FF), f32),
        "w_down": jax.random.normal(ks[12], (DEPTH, D_FF, D_MODEL), f32) * D_FF ** -0.5,
        "ffn_post_norm_w": gain(ks[13], D_MODEL),
    }


def reference(x, meta_tokens, attn_pre_norm_w, w_in, ret_gn_w, sb_norm_w, w_out,
              attn_post_norm_w, ffn_pre_norm_w, w_up, conv_w, conv_b, w_down, ffn_post_norm_w):
    b = x.shape[0]
    meta = jnp.broadcast_to(meta_tokens[None].astype(x.dtype), (b, N_META, x.shape[-1]))
    h = jnp.concatenate([meta, x], axis=1)
    for l in range(DEPTH):
        a = hybrid_mixer(rms_norm(h, attn_pre_norm_w[l]), w_in[l], ret_gn_w[l], sb_norm_w[l], w_out[l])
        h = h + rms_norm(a, attn_post_norm_w[l])
        f = conv_ffn(rms_norm(h, ffn_pre_norm_w[l]), w_up[l], conv_w[l], conv_b[l], w_down[l])
        h = h + rms_norm(f, ffn_post_norm_w[l])
    return h[:, N_META:]
```

```cpp
#include <hip/hip_runtime.h>
#include <cstdio>
#include <cstdint>
namespace pg8 {
#define PG8_LAS __attribute__((address_space(3)))
typedef unsigned short bf16_t;
typedef short bf16x8 __attribute__((ext_vector_type(8)));
typedef float f32x4 __attribute__((ext_vector_type(4)));
typedef unsigned u32x4 __attribute__((ext_vector_type(4)));
constexpr int BM = 256, BK = 64, HALF = 128, HTB = HALF * BK * 2  , STAGE_BYTES = 8 * HTB, NXCD = 8, WGM = 8;

__host__ __device__ __forceinline__ int lds_byte(int r, int c) { const int st = (r >> 4) * 2 + (c >> 5), rr = r & 15, cc = c & 31, ob = rr * 64 + cc * 2; return st * 1024 + (ob ^ (((ob >> 9) & 1) << 5)); }
__host__ __device__ __forceinline__ void stage_rc(int b, int& R, int& C) { const int st = b / 1024, sb = b % 1024, swz = sb ^ (((sb >> 9) & 1) << 5); R = (st >> 1) * 16 + swz / 64; C = (st & 1) * 32 + (swz % 64) / 2; }
__host__ __device__ __forceinline__ int perm32(int rho) { const int n = rho >> 4, i = rho & 15; return 8 * (i >> 2) + 4 * n + (i & 3); }

struct Unit { int pm, pn; };
struct Gemm { const bf16_t* A; const bf16_t* Bt; int M, N, K; };

struct StaticOrder {
    int nM, nN, nwg, G, c;
    __host__ __device__ void init(int M, int N, int G_, int c_) { nM = M / BM; nN = N / BM; nwg = nM * nN; G = G_; c = c_; }
    __host__ __device__ bool next(int i, Unit& u) const {
        const long L = (long)i * G + c; if (L >= nwg) return false;
        int wgid = (int)L; { const int q = nwg / NXCD, r = nwg % NXCD, xcd = wgid % NXCD, off = wgid / NXCD; wgid = (xcd < r ? xcd * (q + 1) : r * (q + 1) + (xcd - r) * q) + off; }
        const int nig = WGM * nN, gid = wgid / nig, fm = gid * WGM, gsz = (nM - fm) < WGM ? (nM - fm) : WGM;
        u.pm = fm + ((wgid % nig) % gsz); u.pn = (wgid % nig) / gsz; return true;
    }
    __device__ __forceinline__ void a_ready(const Unit&) const {}
    __device__ __forceinline__ void done(const Unit&) const {}
};

__device__ __forceinline__ unsigned cvt_pk_bf16(float lo, float hi) { unsigned r; asm volatile("v_cvt_pk_bf16_f32 %0, %1, %2" : "=v"(r) : "v"(lo), "v"(hi)); return r; }

struct EpiProj {
    static constexpr bool PERM = true, AFTER_DRAIN = false;
    bf16_t* O; int ldc; const float* rope_rev;
    __device__ __forceinline__ void operator()(const f32x4 (&acc)[2][2][4][2], const Unit& u, int wr, int wc, int fr, int fq) const {
        const int row0 = u.pm * BM + wr * 64 + fr, col0 = u.pn * BM + wc * 32 + 8 * fq;
        if (u.pn < 16) {
            const f32x4 iv0 = *(const f32x4*)(rope_rev + wc * 32 + 8 * fq), iv1 = *(const f32x4*)(rope_rev + wc * 32 + 8 * fq + 4);
            const float sc = u.pn < 8 ? 0.0625f : 1.0f;
#pragma unroll
            for (int ai = 0; ai < 2; ++ai)
#pragma unroll
                for (int m = 0; m < 4; ++m) {
                    const int row = row0 + ai * HALF + m * 16;
                    const float pos = row < 16384 ? (float)((row & 4095) + 16) : (float)(row - 16384);
                    bf16_t* rowp = O + (size_t)row * ldc + col0;
                    float o0[8], o1[8];
#pragma unroll
                    for (int n = 0; n < 2; ++n)
#pragma unroll
                        for (int j = 0; j < 4; ++j) {
                            float t = pos * (n ? iv1[j] : iv0[j]); t = t - floorf(t);
                            const float s = __builtin_amdgcn_sinf(t), c = __builtin_amdgcn_cosf(t);
                            const float x1 = acc[ai][0][m][n][j], x2 = acc[ai][1][m][n][j];
                            o0[n * 4 + j] = (x1 * c - x2 * s) * sc; o1[n * 4 + j] = (x1 * s + x2 * c) * sc;
                        }
                    u32x4 w; w.x = cvt_pk_bf16(o0[0], o0[1]); w.y = cvt_pk_bf16(o0[2], o0[3]); w.z = cvt_pk_bf16(o0[4], o0[5]); w.w = cvt_pk_bf16(o0[6], o0[7]);
                    *(u32x4*)(rowp) = w;
                    w.x = cvt_pk_bf16(o1[0], o1[1]); w.y = cvt_pk_bf16(o1[2], o1[3]); w.z = cvt_pk_bf16(o1[4], o1[5]); w.w = cvt_pk_bf16(o1[6], o1[7]);
                    *(u32x4*)(rowp + HALF) = w;
                }
        } else {
            const float sc = (u.pn >= 32 && u.pn < 40) ? 0.12751743082459868f : 1.0f;
#pragma unroll
            for (int ai = 0; ai < 2; ++ai)
#pragma unroll
                for (int m = 0; m < 4; ++m) { bf16_t* rowp = O + (size_t)(row0 + ai * HALF + m * 16) * ldc + col0;
#pragma unroll
                    for (int bj = 0; bj < 2; ++bj) { const f32x4 v0 = acc[ai][bj][m][0] * sc, v1 = acc[ai][bj][m][1] * sc;
                        u32x4 w; w.x = cvt_pk_bf16(v0[0], v0[1]); w.y = cvt_pk_bf16(v0[2], v0[3]); w.z = cvt_pk_bf16(v1[0], v1[1]); w.w = cvt_pk_bf16(v1[2], v1[3]);
                        *(u32x4*)(rowp + bj * HALF) = w; } }
        }
    }
};

struct EpiF32Split {
    static constexpr bool PERM = false, AFTER_DRAIN = false;
    float* C0; float* C1; int rows0; int ldc;
    __device__ __forceinline__ void operator()(const f32x4 (&acc)[2][2][4][2], const Unit& u, int wr, int wc, int fr, int fq) const {
        const int row0 = u.pm * BM + wr * 64 + fr, col0 = u.pn * BM + wc * 32 + 4 * fq;
        float* base = row0 < rows0 ? C0 + (size_t)row0 * ldc : C1 + (size_t)(row0 - rows0) * ldc;
#pragma unroll
        for (int ai = 0; ai < 2; ++ai)
#pragma unroll
            for (int m = 0; m < 4; ++m) { float* rowp = base + (size_t)(ai * HALF + m * 16) * ldc + col0;
#pragma unroll
                for (int bj = 0; bj < 2; ++bj)
#pragma unroll
                    for (int n = 0; n < 2; ++n) *(f32x4*)(rowp + bj * HALF + n * 16) = acc[ai][bj][m][n]; }
    }
};

struct EpiConv {
    static constexpr bool PERM = true, AFTER_DRAIN = false;
    bf16_t* ACT; float* HALO; float* FIRSTG; float* FIRSTU; const float* cw; const float* cb; int dff;
    __device__ __forceinline__ void operator()(const f32x4 (&acc)[2][2][4][2], const Unit& u, int wr, int wc, int fr, int fq) const {
        const int lane = fq * 16 + fr, j0 = u.pn * HALF + wc * 32 + 8 * fq;
        if (u.pm == 64) {
            if (wr == 0 && fr >= 14) { float* hp = HALO + ((size_t)256 * 2 + (fr - 14)) * dff + j0; *(f32x4*)hp = acc[0][0][0][0]; *(f32x4*)(hp + 4) = acc[0][0][0][1]; }
            return;
        }
        f32x4 w0[2], w1[2], w2[2], bb[2];
#pragma unroll
        for (int n = 0; n < 2; ++n) { w0[n] = *(const f32x4*)(cw + j0 + 4 * n); w1[n] = *(const f32x4*)(cw + dff + j0 + 4 * n); w2[n] = *(const f32x4*)(cw + 2 * dff + j0 + 4 * n); bb[n] = *(const f32x4*)(cb + j0 + 4 * n); }
        const int s1 = fr >= 1 ? lane - 1 : lane + 15, s2 = fr >= 2 ? lane - 2 : lane + 14;
#pragma unroll
        for (int ai = 0; ai < 2; ++ai) {
            const int sg = u.pm * 4 + ai * 2 + wr;
#pragma unroll
            for (int m = 0; m < 4; ++m) {
                const int row = u.pm * BM + ai * HALF + wr * 64 + m * 16 + fr;
                float o[8];
#pragma unroll
                for (int n = 0; n < 2; ++n)
#pragma unroll
                    for (int j = 0; j < 4; ++j) {
                        const float g = acc[ai][0][m][n][j], gp = m > 0 ? acc[ai][0][m > 0 ? m - 1 : 0][n][j] : 0.f;
                        const float snd1 = fr == 15 ? gp : g, snd2 = fr >= 14 ? gp : g;
                        const float x1 = __shfl(snd1, s1), x2 = __shfl(snd2, s2);
                        const float cv = bb[n][j] + w0[n][j] * x2 + w1[n][j] * x1 + w2[n][j] * g;
                        const float sl = cv * __builtin_amdgcn_rcpf(1.0f + __builtin_amdgcn_exp2f(-1.4426950408889634f * cv));
                        o[n * 4 + j] = sl * acc[ai][1][m][n][j];
                    }
                if (m == 0 && fr < 2) {
                    float* gpz = FIRSTG + ((size_t)sg * 2 + fr) * dff + j0; float* upz = FIRSTU + ((size_t)sg * 2 + fr) * dff + j0;
                    *(f32x4*)gpz = acc[ai][0][0][0]; *(f32x4*)(gpz + 4) = acc[ai][0][0][1]; *(f32x4*)upz = acc[ai][1][0][0]; *(f32x4*)(upz + 4) = acc[ai][1][0][1];
                } else {
                    u32x4 w; w.x = cvt_pk_bf16(o[0], o[1]); w.y = cvt_pk_bf16(o[2], o[3]); w.z = cvt_pk_bf16(o[4], o[5]); w.w = cvt_pk_bf16(o[6], o[7]);
                    *(u32x4*)(ACT + (size_t)row * dff + j0) = w;
                }
                if (m == 3 && fr >= 14) { float* hp = HALO + ((size_t)sg * 2 + (fr - 14)) * dff + j0; *(f32x4*)hp = acc[ai][0][3][0]; *(f32x4*)(hp + 4) = acc[ai][0][3][1]; }
            }
        }
    }
};

template <class Epi, class Sched, bool ALIGN_EPI = false, bool SP2 = false>
__device__ __forceinline__ void gemm_phase(PG8_LAS unsigned char* lds, const Gemm g, const Sched& S, const Epi& E) {
    const int tid = threadIdx.x, wid = __builtin_amdgcn_readfirstlane(tid >> 6), lane = tid & 63, wr = wid >> 2, wc = wid & 3, fr = lane & 15, fq = lane >> 4;
    const int K = g.K, nt = K / BK;
    unsigned voffA[2], voffB[2];
#pragma unroll
    for (int i = 0; i < 2; ++i) { int R, C; stage_rc(tid * 16 + i * 8192, R, C); const int Rb = Epi::PERM ? ((R & ~31) + perm32(R & 31)) : R;
        voffA[i] = (unsigned)(R * K + C) * 2u; voffB[i] = (unsigned)(Rb * K + C) * 2u; }
    const size_t kstep = (size_t)(BK * 2);
    const size_t hstep = (size_t)HALF * K * 2;
    const size_t tstep = 2 * hstep;
    const unsigned ldsw = (unsigned)wid * 1024u;
    const int aoff = lds_byte(wr * 64 + fr, fq * 8), boff = lds_byte(wc * 32 + fr, fq * 8);
#define PG8_SA(b, h) (((b) * 2 + (h)) * HTB)
#define PG8_SB(b, h) ((4 + (b) * 2 + (h)) * HTB)
#define PG8_STAGE(bufoff, gbase, voff) do { _Pragma("unroll") for (int _i = 0; _i < 2; ++_i) \
        __builtin_amdgcn_global_load_lds((const unsigned*)((const char*)(gbase) + (voff)[_i]), (PG8_LAS unsigned*)(lds + (bufoff) + ldsw + _i * 8192), 16, 0, 0); } while (0)
#define PG8_LDA(dst, b, h) do { _Pragma("unroll") for (int m = 0; m < 4; ++m) _Pragma("unroll") for (int k = 0; k < 2; ++k) dst[m][k] = *(const PG8_LAS bf16x8*)(lds + PG8_SA(b, h) + aoff + m * 2048 + k * 1024); } while (0)
#define PG8_LDB(dst, b, h) do { _Pragma("unroll") for (int n = 0; n < 2; ++n) _Pragma("unroll") for (int k = 0; k < 2; ++k) dst[n][k] = *(const PG8_LAS bf16x8*)(lds + PG8_SB(b, h) + boff + n * 2048 + k * 1024); } while (0)
#define PG8_MMA(ai, bj, At, Bt) do { __builtin_amdgcn_s_setprio(1); _Pragma("unroll") for (int m = 0; m < 4; ++m) _Pragma("unroll") for (int n = 0; n < 2; ++n) _Pragma("unroll") for (int k = 0; k < 2; ++k) \
        acc[ai][bj][m][n] = __builtin_amdgcn_mfma_f32_16x16x32_bf16(Bt[n][k], At[m][k], acc[ai][bj][m][n], 0, 0, 0); __builtin_amdgcn_s_setprio(0); } while (0)
#define PG8_WAIT_V(n) asm volatile("s_waitcnt vmcnt(" #n ")" ::: "memory")
#define PG8_WAIT_L(n) asm volatile("s_waitcnt lgkmcnt(" #n ")" ::: "memory")
#define PG8_BAR __builtin_amdgcn_s_barrier()
#define PG8_SCHED __builtin_amdgcn_sched_barrier(0)
    Unit cur, nxt; int ui = 0;
    if (!S.next(0, cur)) return;
    f32x4 acc[2][2][4][2];
#pragma unroll
    for (int a = 0; a < 2; ++a)
#pragma unroll
        for (int b = 0; b < 2; ++b)
#pragma unroll
            for (int m = 0; m < 4; ++m)
#pragma unroll
                for (int n = 0; n < 2; ++n) acc[a][b][m][n] = (f32x4){0.f, 0.f, 0.f, 0.f};
    bf16x8 At[4][2], B0[2][2], B1[2][2];
    const char* cA = (const char*)g.A + (size_t)cur.pm * tstep; const char* cB = (const char*)g.Bt + (size_t)cur.pn * tstep;
    S.a_ready(cur);
    if constexpr (SP2) {
        PG8_STAGE(PG8_SB(0, 0), cB, voffB); PG8_STAGE(PG8_SB(0, 1), cB + hstep, voffB); PG8_STAGE(PG8_SA(0, 0), cA, voffA); PG8_STAGE(PG8_SA(0, 1), cA + hstep, voffA);
        if (wr == 1) PG8_BAR;
        PG8_WAIT_V(2); PG8_BAR;
        PG8_STAGE(PG8_SB(1, 0), cB + kstep, voffB); PG8_STAGE(PG8_SA(1, 0), cA + kstep, voffA); PG8_STAGE(PG8_SB(1, 1), cB + hstep + kstep, voffB);
        PG8_WAIT_V(6); PG8_BAR;
    } else {
        PG8_STAGE(PG8_SB(0, 0), cB, voffB); PG8_STAGE(PG8_SA(0, 0), cA, voffA); PG8_STAGE(PG8_SB(0, 1), cB + hstep, voffB); PG8_STAGE(PG8_SA(0, 1), cA + hstep, voffA);
        if (wr == 1) PG8_BAR;
        PG8_WAIT_V(4); PG8_BAR;
        PG8_STAGE(PG8_SB(1, 0), cB + kstep, voffB); PG8_STAGE(PG8_SA(1, 0), cA + kstep, voffA); PG8_STAGE(PG8_SB(1, 1), cB + hstep + kstep, voffB);
        PG8_WAIT_V(6); PG8_BAR;
    }
    for (;;) {
        const bool has_next = S.next(ui + 1, nxt);
        const char* nA = has_next ? (const char*)g.A + (size_t)nxt.pm * tstep : cA; const char* nB = has_next ? (const char*)g.Bt + (size_t)nxt.pn * tstep : cB;
        for (int t = 0; t < nt; t += 2) {
            const bool last = (t == nt - 2);
            const char* a1 = cA + (size_t)(t + 1) * kstep;
            const char* a2 = last ? nA : cA + (size_t)(t + 2) * kstep; const char* b2 = last ? nB : cB + (size_t)(t + 2) * kstep;
            const char* a3 = a2 + kstep; const char* b3 = b2 + kstep;
            if (last && has_next) S.a_ready(nxt);
            if constexpr (SP2) {
            PG8_LDB(B0, 0, 0); PG8_LDB(B1, 0, 1); PG8_SCHED; PG8_LDA(At, 0, 0); PG8_STAGE(PG8_SA(1, 1), a1 + hstep, voffA);
            PG8_WAIT_V(8); PG8_WAIT_L(0); PG8_BAR; PG8_MMA(0, 0, At, B0); PG8_MMA(0, 1, At, B1); PG8_BAR; PG8_SCHED;
            PG8_LDA(At, 0, 1); PG8_STAGE(PG8_SB(0, 0), b2, voffB); PG8_STAGE(PG8_SB(0, 1), b2 + hstep, voffB); PG8_STAGE(PG8_SA(0, 0), a2, voffA);
            PG8_WAIT_V(8); PG8_WAIT_L(0); PG8_BAR; PG8_MMA(1, 0, At, B0); PG8_MMA(1, 1, At, B1); PG8_BAR; PG8_SCHED;
            PG8_LDB(B0, 1, 0); PG8_LDB(B1, 1, 1); PG8_SCHED; PG8_LDA(At, 1, 0); PG8_STAGE(PG8_SA(0, 1), a2 + hstep, voffA);
            PG8_WAIT_V(8); PG8_WAIT_L(0); PG8_BAR; PG8_MMA(0, 0, At, B0); PG8_MMA(0, 1, At, B1); PG8_BAR; PG8_SCHED;
            PG8_LDA(At, 1, 1); PG8_STAGE(PG8_SB(1, 0), b3, voffB); PG8_STAGE(PG8_SB(1, 1), b3 + hstep, voffB); PG8_STAGE(PG8_SA(1, 0), a3, voffA);
            PG8_WAIT_V(8); PG8_WAIT_L(0); PG8_BAR; PG8_MMA(1, 0, At, B0); PG8_MMA(1, 1, At, B1); PG8_BAR; PG8_SCHED;
            } else {
            PG8_LDB(B0, 0, 0); PG8_SCHED; PG8_LDA(At, 0, 0); PG8_STAGE(PG8_SA(1, 1), a1 + hstep, voffA);
            PG8_WAIT_L(8); PG8_BAR; PG8_WAIT_L(0); PG8_MMA(0, 0, At, B0); PG8_BAR; PG8_SCHED;
            PG8_LDB(B1, 0, 1); PG8_STAGE(PG8_SB(0, 0), b2, voffB);
            PG8_BAR; PG8_WAIT_L(0); PG8_MMA(0, 1, At, B1); PG8_BAR;
            PG8_LDA(At, 0, 1); PG8_STAGE(PG8_SA(0, 0), a2, voffA);
            PG8_BAR; PG8_WAIT_L(0); PG8_MMA(1, 0, At, B0); PG8_BAR; PG8_SCHED;
            PG8_STAGE(PG8_SB(0, 1), b2 + hstep, voffB);
            PG8_WAIT_V(6); PG8_BAR; PG8_MMA(1, 1, At, B1); PG8_BAR;
            PG8_LDB(B0, 1, 0); PG8_SCHED; PG8_LDA(At, 1, 0); PG8_STAGE(PG8_SA(0, 1), a2 + hstep, voffA);
            PG8_WAIT_L(8); PG8_BAR; PG8_WAIT_L(0); PG8_MMA(0, 0, At, B0); PG8_BAR; PG8_SCHED;
            PG8_LDB(B1, 1, 1); PG8_STAGE(PG8_SB(1, 0), b3, voffB);
            PG8_BAR; PG8_WAIT_L(0); PG8_MMA(0, 1, At, B1); PG8_BAR;
            PG8_LDA(At, 1, 1); PG8_STAGE(PG8_SA(1, 0), a3, voffA);
            PG8_BAR; PG8_WAIT_L(0); PG8_MMA(1, 0, At, B0); PG8_BAR; PG8_SCHED;
            PG8_STAGE(PG8_SB(1, 1), b3 + hstep, voffB);
            PG8_WAIT_V(6); PG8_BAR; PG8_MMA(1, 1, At, B1); PG8_BAR;
            }
        }
        if constexpr (ALIGN_EPI) { if (wr == 0) PG8_BAR; }
        if constexpr (!Epi::AFTER_DRAIN) { E(acc, cur, wr, wc, fr, fq); S.done(cur); }
        if (!has_next) break;
#pragma unroll
        for (int a = 0; a < 2; ++a)
#pragma unroll
            for (int b = 0; b < 2; ++b)
#pragma unroll
                for (int m = 0; m < 4; ++m)
#pragma unroll
                    for (int n = 0; n < 2; ++n) acc[a][b][m][n] = (f32x4){0.f, 0.f, 0.f, 0.f};
        cur = nxt; cA = nA; cB = nB; ++ui;
        if constexpr (ALIGN_EPI) { if (wr == 1) PG8_BAR; }
    }
    PG8_WAIT_V(0);
    if constexpr (!ALIGN_EPI) { if (wr == 0) PG8_BAR; }
    PG8_BAR;
    if constexpr (Epi::AFTER_DRAIN) { E.fused(acc, cur, wr, wc, fr, fq, lds, wid, lane); S.done(cur); }
#undef PG8_SA
#undef PG8_SB
#undef PG8_STAGE
#undef PG8_LDA
#undef PG8_LDB
#undef PG8_MMA
#undef PG8_WAIT_V
#undef PG8_WAIT_L
#undef PG8_BAR
#undef PG8_SCHED
}
}

#ifndef PG8_SP2
#define PG8_SP2 true
#endif
#ifndef PG8_ALIGN
#define PG8_ALIGN true
#endif
#ifndef MK_N_LAUNCHES
#define MK_N_LAUNCHES 1
#endif
constexpr int N_LAUNCHES = MK_N_LAUNCHES;
constexpr int N_PHASES = 9;

constexpr int NWAVES = 8;
constexpr int D = 4096, NB = 4, SEQ = 4096, NMETA = 16;
constexpr int MSEQ = NB * SEQ;
constexpr int MROWS = MSEQ + NMETA;
constexpr int MPAD = 65 * 256;
constexpr int IN_COLS = 14336, DFF = 11008, NUP = 2 * DFF;
constexpr int RET_H = 8, SB_H = 16;
constexpr int C_RQ = 0, C_RK = 2048, C_RV = 4096, C_RG = 6144, C_SQ = 8192, C_SK = 10240, C_SV = 12288;
constexpr float EPS = 1e-6f;

constexpr size_t MiB = 1u << 20;
constexpr size_t WS_CTL = 0, CTL_ZERO_BYTES = 1 * MiB;
constexpr size_t WS_WIN = 1 * MiB;
constexpr size_t WS_WOUT = WS_WIN + (size_t)IN_COLS * D * 2;
constexpr size_t WS_WUP = WS_WOUT + (size_t)D * D * 2;
constexpr size_t WS_WDOWN = WS_WUP + (size_t)NUP * D * 2;
constexpr size_t WS_XN = WS_WDOWN + (size_t)D * DFF * 2;
constexpr size_t WS_PROJ = WS_XN + (size_t)MPAD * D * 2;
constexpr size_t WS_ACT = WS_PROJ;
constexpr size_t WS_META = WS_PROJ + (size_t)MPAD * IN_COLS * 2;
constexpr size_t WS_HALO = WS_META + (size_t)256 * D * 4;
constexpr size_t WS_FIRSTG = WS_HALO + (size_t)257 * 2 * DFF * 4;
constexpr size_t WS_FIRSTU = WS_FIRSTG + (size_t)256 * 2 * DFF * 4;
constexpr size_t WS_END = WS_FIRSTU + (size_t)256 * 2 * DFF * 4;
constexpr size_t WS_F = WS_WIN;
static_assert(WS_F + (size_t)MSEQ * D * 4 <= WS_WDOWN, "F overlay must not reach the w_down copy");
static_assert(WS_ACT + (size_t)MSEQ * DFF * 2 <= WS_META, "ACT overlay inside PROJ");
constexpr int CW_TMO = 0, CW_CODE = 1, CW_BAR = 4096;

constexpr int RING_OFF = 0, RING_BYTES = 131072;
constexpr int LDSCTL_OFF = RING_BYTES, MISC_OFF = LDSCTL_OFF + 320;
constexpr int LDS_BYTES = 147456;
static_assert(MISC_OFF + 128 <= LDS_BYTES, "LDS map");

#define GAS __attribute__((address_space(1)))
#define LAS __attribute__((address_space(3)))
typedef unsigned short bf16;
typedef unsigned v4u __attribute__((ext_vector_type(4)));
typedef unsigned v2u __attribute__((ext_vector_type(2)));
typedef float f32x4 __attribute__((ext_vector_type(4)));
typedef short bf16x8 __attribute__((ext_vector_type(8)));
typedef GAS unsigned gu32;
#define RLX_AGENT __ATOMIC_RELAXED, __HIP_MEMORY_SCOPE_AGENT
#define LDS_WAIT() asm volatile("s_waitcnt lgkmcnt(0)" ::: "memory")
#define VM_WAIT() asm volatile("s_waitcnt vmcnt(0)" ::: "memory")
__device__ __forceinline__ unsigned f2bf(float f) { unsigned u = __builtin_bit_cast(unsigned, f); return (u + 0x7fffu + ((u >> 16) & 1u)) >> 16; }
__device__ __forceinline__ unsigned pk2(float lo, float hi) { return f2bf(lo) | (f2bf(hi) << 16); }
__device__ __forceinline__ float bflo(unsigned w) { return __builtin_bit_cast(float, w << 16); }
__device__ __forceinline__ float bfhi(unsigned w) { return __builtin_bit_cast(float, w & 0xffff0000u); }

__device__ const float ROPE_REV[128] = {1.591549367e-01f, 1.481051445e-01f, 1.378225088e-01f, 1.282537580e-01f, 1.193493754e-01f, 1.110631898e-01f, 1.033523008e-01f, 9.617675841e-02f, 8.949939907e-02f, 8.328563720e-02f, 7.750329375e-02f, 7.212239504e-02f, 6.711508334e-02f, 6.245541945e-02f, 5.811926723e-02f, 5.408416688e-02f, 5.032921210e-02f, 4.683495313e-02f, 4.358330369e-02f, 4.055740312e-02f, 3.774158657e-02f, 3.512126580e-02f, 3.268286586e-02f, 3.041376360e-02f, 2.830219641e-02f, 2.633723244e-02f, 2.450869232e-02f, 2.280710265e-02f, 2.122365125e-02f, 1.975013874e-02f, 1.837892644e-02f, 1.710291393e-02f, 1.591549441e-02f, 1.481051464e-02f, 1.378224976e-02f, 1.282537542e-02f, 1.193493605e-02f, 1.110631879e-02f, 1.033523027e-02f, 9.617676027e-03f, 8.949940093e-03f, 8.328564465e-03f, 7.750329096e-03f, 7.212239318e-03f, 6.711508613e-03f, 6.245541386e-03f, 5.811926443e-03f, 5.408416502e-03f, 5.032920744e-03f, 4.683495499e-03f, 4.358330276e-03f, 4.055740312e-03f, 3.774158657e-03f, 3.512126161e-03f, 3.268286819e-03f, 3.041375894e-03f, 2.830219688e-03f, 2.633722965e-03f, 2.450869186e-03f, 2.280710265e-03f, 2.122365404e-03f, 1.975013874e-03f, 1.837892691e-03f, 1.710291486e-03f, 1.591549371e-03f, 1.481051324e-03f, 1.378225046e-03f, 1.282537705e-03f, 1.193493721e-03f, 1.110631856e-03f, 1.033522887e-03f, 9.617675678e-04f, 8.949940093e-04f, 8.328563999e-04f, 7.750329096e-04f, 7.212238852e-04f, 6.711508031e-04f, 6.245541736e-04f, 5.811926676e-04f, 5.408416619e-04f, 5.032921326e-04f, 4.683495790e-04f, 4.358330334e-04f, 4.055740428e-04f, 3.774158249e-04f, 3.512126568e-04f, 3.268286237e-04f, 3.041376185e-04f, 2.830219746e-04f, 2.633723198e-04f, 2.450869069e-04f, 2.280710323e-04f, 2.122365258e-04f, 1.975013729e-04f, 1.837892487e-04f, 1.710291544e-04f, 1.591549517e-04f, 1.481051440e-04f, 1.378224988e-04f, 1.282537705e-04f, 1.193493736e-04f, 1.110631856e-04f, 1.033523004e-04f, 9.617675823e-05f, 8.949940093e-05f, 8.328563854e-05f, 7.750328950e-05f, 7.212239143e-05f, 6.711508468e-05f, 6.245541590e-05f, 5.811926894e-05f, 5.408416473e-05f, 5.032921035e-05f, 4.683495354e-05f, 4.358330261e-05f, 4.055740283e-05f, 3.774158540e-05f, 3.512126204e-05f, 3.268286673e-05f, 3.041376112e-05f, 2.830219637e-05f, 2.633723307e-05f, 2.450869033e-05f, 2.280710214e-05f, 2.122365368e-05f, 1.975013765e-05f, 1.837892705e-05f, 1.710291508e-05f};


#define XB_TMO      128
#define XB_XCNT(j)  (256  + 64 * (j))
#define XB_XSUB(j)  (1280 + 64 * (j))
#define XB_XGEN(j)  (2304 + 64 * (j))
#define XB_TOP      3328
#define XB_TOPGEN   3392
#define XCD_BAR_WORDS 3456
#define XB_SPIN_CAP (1u << 22)

__device__ __forceinline__ unsigned xb_ld(unsigned* p)              { return __hip_atomic_load(p, __ATOMIC_RELAXED, __HIP_MEMORY_SCOPE_AGENT); }
__device__ __forceinline__ unsigned xb_add(unsigned* p, unsigned v) { return __hip_atomic_fetch_add(p, v, __ATOMIC_RELAXED, __HIP_MEMORY_SCOPE_AGENT); }
__device__ __forceinline__ unsigned xb_xcc_id() { return (unsigned)__builtin_amdgcn_s_getreg((3 << 11) | 20) & 0xFu; }
#define XB_SPIN(cond, bar) do { unsigned _sp = 0; while (cond) { __builtin_amdgcn_s_sleep(1); \
    if ((++_sp & 255u) == 0u) { if (xb_ld(&(bar)[XB_TMO])) break; if (_sp > XB_SPIN_CAP) { atomicAdd(&(bar)[XB_TMO], 1u); break; } } } } while (0)

struct XcdBarrier {
    unsigned* bar; unsigned x;
    volatile LAS unsigned* st;
};

__device__ __forceinline__ XcdBarrier xcd_barrier_post(unsigned* bar, volatile LAS unsigned* st) {
    XcdBarrier b; b.bar = bar; b.x = xb_xcc_id(); b.st = st;
    if (threadIdx.x == 0) (void)xb_add(&bar[XB_XCNT(b.x)], 1u);
    return b;
}
__device__ __forceinline__ void xcd_barrier_complete(unsigned* bar, unsigned x, unsigned& nloc, unsigned& nx) {
    const unsigned G = gridDim.x * gridDim.y * gridDim.z;
    unsigned sum, cnt, mine, sp = 0u;
    for (;;) {
        sum = 0u; cnt = 0u; mine = 0u;
#pragma unroll
        for (unsigned j = 0; j < 16; ++j) { const unsigned c = xb_ld(&bar[XB_XCNT(j)]); sum += c; cnt += (c > 0u) ? 1u : 0u; mine = (j == x) ? c : mine; }
        if (sum == G) break;
        __builtin_amdgcn_s_sleep(1);
        if ((++sp & 255u) == 0u) { if (xb_ld(&bar[XB_TMO])) break; if (sp > XB_SPIN_CAP) { atomicAdd(&bar[XB_TMO], 1u); break; } }
    }
    nloc = mine > 0u ? mine : 1u; nx = cnt > 0u ? cnt : 1u;
}

__device__ __forceinline__ void xcd_barrier(const XcdBarrier& b) {
    asm volatile("s_waitcnt vmcnt(0)" ::: "memory");
    __syncthreads();
    if (threadIdx.x == 0) {
        unsigned* bar = b.bar;
        __builtin_amdgcn_s_waitcnt(0);
        unsigned nloc = b.st[0], nx = b.st[1];
        if (nloc == 0u) { xcd_barrier_complete(bar, b.x, nloc, nx); b.st[0] = nloc; b.st[1] = nx; }
        const unsigned old = xb_add(&bar[XB_XSUB(b.x)], 1u);
        const unsigned gen = old / nloc;
        if (old + 1u == (gen + 1u) * nloc) {
            __builtin_amdgcn_fence(__ATOMIC_RELEASE, "agent");
            asm volatile("s_waitcnt vmcnt(0)" ::: "memory");
            const unsigned og = xb_add(&bar[XB_TOP], 1u);
            const unsigned tg = og / nx;
            if (og + 1u == (tg + 1u) * nx) xb_add(&bar[XB_TOPGEN], 1u);
            else XB_SPIN(xb_ld(&bar[XB_TOPGEN]) == tg, bar);
            __builtin_amdgcn_fence(__ATOMIC_ACQUIRE, "agent");
            xb_add(&bar[XB_XGEN(b.x)], 1u);
            asm volatile("s_waitcnt vmcnt(0)" ::: "memory");
        } else {
            XB_SPIN(xb_ld(&bar[XB_XGEN(b.x)]) == gen, bar);
            __builtin_amdgcn_fence(__ATOMIC_ACQUIRE, "agent");
            asm volatile("s_waitcnt vmcnt(0)" ::: "memory");
        }
    }
    __syncthreads();
}


struct Frame {
    LAS unsigned char* lds;
    volatile LAS unsigned* MISC;
    gu32* ctl;
    int tid, lane, wave, vcu, G;
    const float *x, *meta, *w_pre, *w_in, *gn_w, *sbn_w, *w_out, *w_post, *w_pre2, *w_up, *conv_w, *conv_b, *w_down, *w_post2;
    float* out;
    bf16 *WIN, *WOUT, *WUP, *WDOWN, *XN, *PROJ, *ACT;
    float *META, *HALO, *FIRSTG, *FIRSTU, *Fb;
};
__device__ __forceinline__ float wave_sum(float v) {
#pragma unroll
    for (int o = 1; o < 64; o <<= 1) v += __shfl_xor(v, o);
    return v;
}
__device__ __forceinline__ void p0_transpose_item(const float* W, int K, int N, bf16* WT, int k0, int n0, int dst0, LAS float* scr, int lane) {
#pragma unroll 8
    for (int i = 0; i < 32; ++i) { const int kk = 2 * i + (lane >> 5); scr[kk * 33 + (lane & 31)] = W[(size_t)(k0 + kk) * N + n0 + (lane & 31)]; }
    LDS_WAIT(); asm volatile("" ::: "memory");
    const int c = lane & 7;
#pragma unroll
    for (int j = 0; j < 4; ++j) { const int n = (lane >> 3) + 8 * j; const LAS float* s = scr + (8 * c) * 33 + n;
        v4u o; o.x = pk2(s[0 * 33], s[1 * 33]); o.y = pk2(s[2 * 33], s[3 * 33]); o.z = pk2(s[4 * 33], s[5 * 33]); o.w = pk2(s[6 * 33], s[7 * 33]);
        *(GAS v4u*)(WT + (size_t)(dst0 + n) * K + k0 + 8 * c) = o; }
    LDS_WAIT(); asm volatile("" ::: "memory");
}
__device__ __forceinline__ const float* h_row(Frame& F, int r) { return r < MSEQ ? F.x + (size_t)r * D : F.meta + (size_t)(r - MSEQ) * D; }

__device__ __forceinline__ void p0_prologue(Frame& F) {
    LAS float* scr = (LAS float*)(F.lds + RING_OFF + F.wave * 16384);
    const int gw = F.vcu * NWAVES + F.wave, NGW = F.G * NWAVES;
    constexpr int I_IN = (D / 64) * (IN_COLS / 32), I_OUT = (D / 64) * (D / 32), I_UP = (D / 64) * (NUP / 32), I_DN = (DFF / 64) * (D / 32);
    constexpr int NITEMS = I_IN + I_OUT + I_UP + I_DN;
    for (int it = gw; it < NITEMS; it += NGW) {
        int r = it;
        if (r < I_IN) { const int nb = IN_COLS / 32, kb = r / nb, n0 = 32 * (r % nb); p0_transpose_item(F.w_in, D, IN_COLS, F.WIN, 64 * kb, n0, n0, scr, F.lane); continue; } r -= I_IN;
        if (r < I_OUT) { const int nb = D / 32, kb = r / nb, n0 = 32 * (r % nb); p0_transpose_item(F.w_out, D, D, F.WOUT, 64 * kb, n0, n0, scr, F.lane); continue; } r -= I_OUT;
        if (r < I_UP) { const int nb = NUP / 32, kb = r / nb, n0 = 32 * (r % nb); const int up = n0 >= DFF, j = up ? n0 - DFF : n0;
            p0_transpose_item(F.w_up, D, NUP, F.WUP, 64 * kb, n0, (j >> 7) * 256 + up * 128 + (j & 127), scr, F.lane); continue; } r -= I_UP;
        { const int nb = D / 32, kb = r / nb, n0 = 32 * (r % nb); p0_transpose_item(F.w_down, DFF, D, F.WDOWN, 64 * kb, n0, n0, scr, F.lane); }
    }
    for (int m = gw; m < MROWS; m += NGW) {
        const GAS f32x4* xr = (const GAS f32x4*)h_row(F, m) + F.lane; const GAS f32x4* wr4 = (const GAS f32x4*)F.w_pre + F.lane;
        f32x4 v[16]; float s = 0.f;
#pragma unroll
        for (int j = 0; j < 16; ++j) { v[j] = xr[64 * j]; s += (v[j].x * v[j].x + v[j].y * v[j].y) + (v[j].z * v[j].z + v[j].w * v[j].w); }
        const float r = 1.0f / sqrtf(wave_sum(s) * (1.f / D) + EPS);
        GAS v2u* o8 = (GAS v2u*)(F.XN + (size_t)m * D) + F.lane;
#pragma unroll
        for (int j = 0; j < 16; ++j) { const f32x4 w = wr4[64 * j]; v2u o; o.x = pk2(v[j].x * r * w.x, v[j].y * r * w.y); o.y = pk2(v[j].z * r * w.z, v[j].w * r * w.w); o8[64 * j] = o; }
    }
}

__device__ __forceinline__ size_t pos_row(int b, int p) { return p < NMETA ? (size_t)(MSEQ + p) : (size_t)(b * SEQ + p - NMETA); }

__device__ __forceinline__ void p2_retention_naive(Frame& F) {
    LAS float* qs = (LAS float*)(F.lds + RING_OFF + F.wave * 2048);
    const int gw = F.vcu * NWAVES + F.wave, NGW = F.G * NWAVES, lane = F.lane;
    for (int item = gw; item < RET_H * MROWS; item += NGW) {
        const int h = item % RET_H, rr = item / RET_H;
        int b, n; if (rr < MSEQ) { b = rr >> 12; n = (rr & 4095) + NMETA; } else { b = 0; n = rr - MSEQ; }
        const bf16* qrow = F.PROJ + (size_t)rr * IN_COLS;
        { const v2u qv = *(const GAS v2u*)(qrow + C_RQ + h * 256 + 4 * lane); *(LAS f32x4*)(qs + 4 * lane) = (f32x4){bflo(qv.x), bfhi(qv.x), bflo(qv.y), bfhi(qv.y)}; }
        LDS_WAIT(); asm volatile("" ::: "memory");
        const float lg = log2f(1.0f - exp2f(-5.0f - (float)h));
        float o0 = 0.f, o1 = 0.f, o2 = 0.f, o3 = 0.f;
        for (int p0 = 0; p0 <= n; p0 += 64) {
            const int p = p0 + lane; const bool valid = p <= n; const int pc = valid ? p : n;
            const bf16* kp = F.PROJ + pos_row(b, pc) * IN_COLS + C_RK + h * 256;
            float s = 0.f;
#pragma unroll 4
            for (int c = 0; c < 32; ++c) { const v4u kv = *(const GAS v4u*)(kp + 8 * c); const f32x4 qa = *(const LAS f32x4*)(qs + 8 * c), qb = *(const LAS f32x4*)(qs + 8 * c + 4);
                s += bflo(kv.x) * qa.x + bfhi(kv.x) * qa.y + bflo(kv.y) * qa.z + bfhi(kv.y) * qa.w + bflo(kv.z) * qb.x + bfhi(kv.z) * qb.y + bflo(kv.w) * qb.z + bfhi(kv.w) * qb.w; }
            s = valid ? s * exp2f((float)(n - p) * lg) : 0.f;
            const int cnt = (n - p0 + 1) < 64 ? (n - p0 + 1) : 64;
#pragma unroll 4
            for (int l = 0; l < cnt; ++l) {
                const float sl = __builtin_bit_cast(float, __builtin_amdgcn_readlane(__builtin_bit_cast(int, s), l));
                const v2u vv = *(const GAS v2u*)(F.PROJ + pos_row(b, p0 + l) * IN_COLS + C_RV + h * 256 + 4 * lane);
                o0 += sl * bflo(vv.x); o1 += sl * bfhi(vv.x); o2 += sl * bflo(vv.y); o3 += sl * bfhi(vv.y);
            }
        }
        const float ss = wave_sum(o0 * o0 + o1 * o1 + o2 * o2 + o3 * o3);
        const float r = 1.0f / sqrtf(ss * (1.f / 256.f) + EPS);
        const f32x4 gw4 = *(const GAS f32x4*)(F.gn_w + h * 256 + 4 * lane);
        const v2u gv = *(const GAS v2u*)(qrow + C_RG + h * 256 + 4 * lane);
        const float g0 = bflo(gv.x), g1 = bfhi(gv.x), g2 = bflo(gv.y), g3 = bfhi(gv.y);
        const float y0 = g0 / (1.f + __expf(-g0)) * (o0 * r * gw4.x), y1 = g1 / (1.f + __expf(-g1)) * (o1 * r * gw4.y);
        const float y2 = g2 / (1.f + __expf(-g2)) * (o2 * r * gw4.z), y3 = g3 / (1.f + __expf(-g3)) * (o3 * r * gw4.w);
        v2u ov; ov.x = pk2(y0, y1); ov.y = pk2(y2, y3);
        *(GAS v2u*)(F.XN + (size_t)rr * D + h * 256 + 4 * lane) = ov;
        LDS_WAIT(); asm volatile("" ::: "memory");
    }
}

__device__ __forceinline__ void p2_stickbreak_naive(Frame& F) {
    LAS float* qs = (LAS float*)(F.lds + RING_OFF + F.wave * 2048);
    const int gw = F.vcu * NWAVES + F.wave, NGW = F.G * NWAVES, lane = F.lane;
    for (int item = gw; item < SB_H * MROWS; item += NGW) {
        const int h = item % SB_H, rr = item / SB_H;
        int b, n; if (rr < MSEQ) { b = rr >> 12; n = (rr & 4095) + NMETA; } else { b = 0; n = rr - MSEQ; }
        const bf16* qrow = F.PROJ + (size_t)rr * IN_COLS;
        { const unsigned qv = *(const GAS unsigned*)(qrow + C_SQ + h * 128 + 2 * lane); qs[2 * lane] = bflo(qv); qs[2 * lane + 1] = bfhi(qv); }
        LDS_WAIT(); asm volatile("" ::: "memory");
        float o0 = 0.f, o1 = 0.f, R = 0.f;
        for (int t0 = 0; t0 < n; t0 += 64) {
            const int p = n - 1 - (t0 + lane); const bool valid = p >= 0; const int pc = valid ? p : 0;
            const bf16* kp = F.PROJ + pos_row(b, pc) * IN_COLS + C_SK + h * 128;
            float z = 0.f;
#pragma unroll 4
            for (int c = 0; c < 16; ++c) { const v4u kv = *(const GAS v4u*)(kp + 8 * c); const f32x4 qa = *(const LAS f32x4*)(qs + 8 * c), qb = *(const LAS f32x4*)(qs + 8 * c + 4);
                z += bflo(kv.x) * qa.x + bfhi(kv.x) * qa.y + bflo(kv.y) * qa.z + bfhi(kv.y) * qa.w + bflo(kv.z) * qb.x + bfhi(kv.z) * qb.y + bflo(kv.w) * qb.z + bfhi(kv.w) * qb.w; }
            const float sp = fmaxf(z, 0.f) + log2f(1.0f + exp2f(-fabsf(z)));
            const float lk = valid ? -sp : 0.f;
            float inc = lk;
#pragma unroll
            for (int o = 1; o < 64; o <<= 1) { const float t = __shfl_up(inc, o); if (lane >= o) inc += t; }
            const float after = R + (inc - lk);
            const float w = valid ? exp2f(z - sp + after) : 0.f;
            R += __builtin_bit_cast(float, __builtin_amdgcn_readlane(__builtin_bit_cast(int, inc), 63));
            const int cnt = (n - t0) < 64 ? (n - t0) : 64;
#pragma unroll 4
            for (int l = 0; l < cnt; ++l) {
                const float wl = __builtin_bit_cast(float, __builtin_amdgcn_readlane(__builtin_bit_cast(int, w), l));
                const unsigned vv = *(const GAS unsigned*)(F.PROJ + pos_row(b, n - 1 - (t0 + l)) * IN_COLS + C_SV + h * 128 + 2 * lane);
                o0 += wl * bflo(vv); o1 += wl * bfhi(vv);
            }
            if (R < -160.f) break;
        }
        const float ss = wave_sum(o0 * o0 + o1 * o1);
        const float r = 1.0f / sqrtf(ss * (1.f / 128.f) + EPS);
        const float w0 = F.sbn_w[h * 128 + 2 * lane], w1 = F.sbn_w[h * 128 + 2 * lane + 1];
        *(GAS unsigned*)(F.XN + (size_t)rr * D + 2048 + h * 128 + 2 * lane) = pk2(o0 * r * w0, o1 * r * w1);
        LDS_WAIT(); asm volatile("" ::: "memory");
    }
}

__device__ __forceinline__ void p4_norms(Frame& F) {
    const int gw = F.vcu * NWAVES + F.wave, NGW = F.G * NWAVES;
    for (int m = gw; m < MROWS; m += NGW) {
        GAS f32x4* ar = (GAS f32x4*)(m < MSEQ ? F.out + (size_t)m * D : F.META + (size_t)(m - MSEQ) * D) + F.lane;
        const GAS f32x4* hr = (const GAS f32x4*)h_row(F, m) + F.lane;
        const GAS f32x4* wp = (const GAS f32x4*)F.w_post + F.lane; const GAS f32x4* wq = (const GAS f32x4*)F.w_pre2 + F.lane;
        f32x4 v[16]; float s = 0.f;
#pragma unroll
        for (int j = 0; j < 16; ++j) { v[j] = ar[64 * j]; s += (v[j].x * v[j].x + v[j].y * v[j].y) + (v[j].z * v[j].z + v[j].w * v[j].w); }
        const float r = 1.0f / sqrtf(wave_sum(s) * (1.f / D) + EPS); float s2 = 0.f;
#pragma unroll
        for (int j = 0; j < 16; ++j) { const f32x4 w = wp[64 * j], hv = hr[64 * j]; v[j] = hv + v[j] * r * w; ar[64 * j] = v[j]; s2 += (v[j].x * v[j].x + v[j].y * v[j].y) + (v[j].z * v[j].z + v[j].w * v[j].w); }
        const float r2 = 1.0f / sqrtf(wave_sum(s2) * (1.f / D) + EPS);
        GAS v2u* o8 = (GAS v2u*)(F.XN + (size_t)m * D) + F.lane;
#pragma unroll
        for (int j = 0; j < 16; ++j) { const f32x4 w = wq[64 * j]; v2u o; o.x = pk2(v[j].x * r2 * w.x, v[j].y * r2 * w.y); o.y = pk2(v[j].z * r2 * w.z, v[j].w * r2 * w.w); o8[64 * j] = o; }
    }
}

__device__ __forceinline__ void p6_fixup(Frame& F) {
    const int gt = F.vcu * (NWAVES * 64) + F.tid, NGT = F.G * NWAVES * 64;
    constexpr int QC = DFF / 4;
    for (int i = gt; i < 256 * QC; i += NGT) {
        const int sg = i / QC, jq = i % QC, j = 4 * jq;
        const int prev = (sg & 63) == 0 ? 256 : sg - 1;
        const f32x4 h0 = *(const GAS f32x4*)(F.HALO + ((size_t)prev * 2 + 0) * DFF + j), h1 = *(const GAS f32x4*)(F.HALO + ((size_t)prev * 2 + 1) * DFF + j);
        const f32x4 g0 = *(const GAS f32x4*)(F.FIRSTG + ((size_t)sg * 2 + 0) * DFF + j), g1 = *(const GAS f32x4*)(F.FIRSTG + ((size_t)sg * 2 + 1) * DFF + j);
        const f32x4 u0 = *(const GAS f32x4*)(F.FIRSTU + ((size_t)sg * 2 + 0) * DFF + j), u1 = *(const GAS f32x4*)(F.FIRSTU + ((size_t)sg * 2 + 1) * DFF + j);
        const f32x4 w0 = *(const GAS f32x4*)(F.conv_w + j), w1 = *(const GAS f32x4*)(F.conv_w + DFF + j), w2 = *(const GAS f32x4*)(F.conv_w + 2 * DFF + j), bb = *(const GAS f32x4*)(F.conv_b + j);
        float a0[4], a1[4];
#pragma unroll
        for (int e = 0; e < 4; ++e) {
            const float c0 = bb[e] + w0[e] * h0[e] + w1[e] * h1[e] + w2[e] * g0[e];
            const float c1 = bb[e] + w0[e] * h1[e] + w1[e] * g0[e] + w2[e] * g1[e];
            a0[e] = c0 / (1.f + __expf(-c0)) * u0[e]; a1[e] = c1 / (1.f + __expf(-c1)) * u1[e];
        }
        v2u o; o.x = pk2(a0[0], a0[1]); o.y = pk2(a0[2], a0[3]); *(GAS v2u*)(F.ACT + (size_t)(sg * 64) * DFF + j) = o;
        o.x = pk2(a1[0], a1[1]); o.y = pk2(a1[2], a1[3]); *(GAS v2u*)(F.ACT + (size_t)(sg * 64 + 1) * DFF + j) = o;
    }
}

__device__ __forceinline__ void p8_final(Frame& F) {
    const int gw = F.vcu * NWAVES + F.wave, NGW = F.G * NWAVES;
    for (int m = gw; m < MSEQ; m += NGW) {
        GAS f32x4* orow = (GAS f32x4*)(F.out + (size_t)m * D) + F.lane; const GAS f32x4* fr = (const GAS f32x4*)(F.Fb + (size_t)m * D) + F.lane;
        const GAS f32x4* wp = (const GAS f32x4*)F.w_post2 + F.lane;
        f32x4 v[16]; float s = 0.f;
#pragma unroll
        for (int j = 0; j < 16; ++j) { v[j] = fr[64 * j]; s += (v[j].x * v[j].x + v[j].y * v[j].y) + (v[j].z * v[j].z + v[j].w * v[j].w); }
        const float r = 1.0f / sqrtf(wave_sum(s) * (1.f / D) + EPS);
#pragma unroll
        for (int j = 0; j < 16; ++j) { const f32x4 w = wp[64 * j]; orow[64 * j] = orow[64 * j] + v[j] * r * w; }
    }
}

struct Args { const float* in[14]; float* out; unsigned char* ws; int ph_lo, ph_hi; };
__global__ void __launch_bounds__(NWAVES * 64, 2) hymba_fwd(Args args) {
    extern __shared__ __attribute__((aligned(16))) unsigned char lds[];
    Frame F;
    F.lds = (LAS unsigned char*)lds;
    F.MISC = (volatile LAS unsigned*)(F.lds + MISC_OFF);
    F.tid = threadIdx.x; F.lane = F.tid & 63; F.wave = __builtin_amdgcn_readfirstlane(F.tid >> 6);
    F.G = gridDim.x; { const int bx = blockIdx.x; F.vcu = (F.G % 8 == 0) ? (bx % 8) * (F.G / 8) + bx / 8 : bx; }
    unsigned char* ws = args.ws;
    F.ctl = (gu32*)(ws + WS_CTL);
    F.x = args.in[0]; F.meta = args.in[1]; F.w_pre = args.in[2]; F.w_in = args.in[3]; F.gn_w = args.in[4]; F.sbn_w = args.in[5]; F.w_out = args.in[6]; F.w_post = args.in[7];
    F.w_pre2 = args.in[8]; F.w_up = args.in[9]; F.conv_w = args.in[10]; F.conv_b = args.in[11]; F.w_down = args.in[12]; F.w_post2 = args.in[13]; F.out = args.out;
    F.WIN = (bf16*)(ws + WS_WIN); F.WOUT = (bf16*)(ws + WS_WOUT); F.WUP = (bf16*)(ws + WS_WUP); F.WDOWN = (bf16*)(ws + WS_WDOWN); F.XN = (bf16*)(ws + WS_XN);
    F.PROJ = (bf16*)(ws + WS_PROJ); F.ACT = (bf16*)(ws + WS_ACT); F.META = (float*)(ws + WS_META); F.HALO = (float*)(ws + WS_HALO); F.FIRSTG = (float*)(ws + WS_FIRSTG);
    F.FIRSTU = (float*)(ws + WS_FIRSTU); F.Fb = (float*)(ws + WS_F);
    for (int u = F.tid; u < (LDS_BYTES - LDSCTL_OFF) / 4; u += NWAVES * 64) ((LAS unsigned*)(F.lds + LDSCTL_OFF))[u] = 0u;
    __syncthreads();
    XcdBarrier bar; bar.bar = (unsigned*)(F.ctl + CW_BAR); bar.x = 0; bar.st = nullptr;
    if (N_LAUNCHES == 1) bar = xcd_barrier_post((unsigned*)(F.ctl + CW_BAR), F.MISC + 8);
#define GRID_BAR() do { if (N_LAUNCHES == 1) xcd_barrier(bar); } while (0)
    const int lo = args.ph_lo, hi = args.ph_hi;
#define IN(k) (lo <= (k) && (k) < hi)
#define BOTH(k) (IN(k) && IN((k) + 1))

    if (IN(0)) { p0_prologue(F); if (BOTH(0)) GRID_BAR(); }
    if (IN(1)) {
        pg8::Gemm g{F.XN, F.WIN, MPAD, IN_COLS, D}; pg8::StaticOrder S; S.init(MPAD, IN_COLS, F.G, (int)blockIdx.x);
        pg8::EpiProj E{F.PROJ, IN_COLS, ROPE_REV};
        pg8::gemm_phase<pg8::EpiProj, pg8::StaticOrder, PG8_ALIGN, PG8_SP2>(F.lds + RING_OFF, g, S, E);
        if (BOTH(1)) GRID_BAR();
    }
    if (IN(2)) { p2_retention_naive(F); p2_stickbreak_naive(F); if (BOTH(2)) GRID_BAR(); }
    if (IN(3)) {
        pg8::Gemm g{F.XN, F.WOUT, MPAD, D, D}; pg8::StaticOrder S; S.init(MPAD, D, F.G, (int)blockIdx.x);
        pg8::EpiF32Split E{F.out, F.META, MSEQ, D};
        pg8::gemm_phase<pg8::EpiF32Split, pg8::StaticOrder, PG8_ALIGN, PG8_SP2>(F.lds + RING_OFF, g, S, E);
        if (BOTH(3)) GRID_BAR();
    }
    if (IN(4)) { p4_norms(F); if (BOTH(4)) GRID_BAR(); }
    if (IN(5)) {
        pg8::Gemm g{F.XN, F.WUP, MPAD, NUP, D}; pg8::StaticOrder S; S.init(MPAD, NUP, F.G, (int)blockIdx.x);
        pg8::EpiConv E{F.ACT, F.HALO, F.FIRSTG, F.FIRSTU, F.conv_w, F.conv_b, DFF};
        pg8::gemm_phase<pg8::EpiConv, pg8::StaticOrder, PG8_ALIGN, PG8_SP2>(F.lds + RING_OFF, g, S, E);
        if (BOTH(5)) GRID_BAR();
    }
    if (IN(6)) { p6_fixup(F); if (BOTH(6)) GRID_BAR(); }
    if (IN(7)) {
        pg8::Gemm g{F.ACT, F.WDOWN, MSEQ, D, DFF}; pg8::StaticOrder S; S.init(MSEQ, D, F.G, (int)blockIdx.x);
        pg8::EpiF32Split E{F.Fb, F.Fb, MSEQ, D};
        pg8::gemm_phase<pg8::EpiF32Split, pg8::StaticOrder, PG8_ALIGN, PG8_SP2>(F.lds + RING_OFF, g, S, E);
        if (BOTH(7)) GRID_BAR();
    }
    if (IN(8)) { p8_final(F); }
#undef IN
#undef BOTH
}

extern "C" void kernel_launch(void* const* d_in, const int* in_sizes, int n_in, void* d_out, int out_size, void* d_ws, size_t ws_size, hipStream_t stream) {
    static int grid = 0;
    if (grid == 0) {
        if (n_in != 14 || out_size != MSEQ * D || ws_size < WS_END) { fprintf(stderr, "kernel_launch: unexpected shapes (n_in %d, out %d, ws %zu < %zu)\n", n_in, out_size, ws_size, (size_t)WS_END); grid = -1; return; }
        int dev = 0, cus = 0, per_cu = 0;
        if (hipGetDevice(&dev) != hipSuccess || hipDeviceGetAttribute(&cus, hipDeviceAttributeMultiprocessorCount, dev) != hipSuccess) { grid = -1; return; }
        if (hipFuncSetAttribute((const void*)hymba_fwd, hipFuncAttributeMaxDynamicSharedMemorySize, LDS_BYTES) != hipSuccess) { fprintf(stderr, "kernel_launch: hipFuncSetAttribute failed\n"); grid = -1; return; }
        if (hipOccupancyMaxActiveBlocksPerMultiprocessor(&per_cu, (const void*)hymba_fwd, NWAVES * 64, LDS_BYTES) != hipSuccess || per_cu < 1) fprintf(stderr, "kernel_launch: occupancy query reports %d\n", per_cu);
        (void)hipGetLastError();
        grid = cus;
    }
    if (grid < 0) return;
    if (hipMemsetAsync((char*)d_ws + WS_CTL, 0, CTL_ZERO_BYTES, stream) != hipSuccess) return;
    Args a{};
    for (int i = 0; i < 14; ++i) a.in[i] = (const float*)d_in[i];
    a.out = (float*)d_out; a.ws = (unsigned char*)d_ws;
    if (N_LAUNCHES == 1) { a.ph_lo = 0; a.ph_hi = N_PHASES; hipLaunchKernelGGL(hymba_fwd, dim3(grid), dim3(NWAVES * 64), LDS_BYTES, stream, a); }
    else for (int p = 0; p < N_PHASES; ++p) { a.ph_lo = p; a.ph_hi = p + 1; hipLaunchKernelGGL(hymba_fwd, dim3(grid), dim3(NWAVES * 64), LDS_BYTES, stream, a); }
    const hipError_t le = hipPeekAtLastError();
    if (le != hipSuccess) fprintf(stderr, "kernel_launch: launch failed: %s\n", hipGetErrorName(le));
}
```

```cpp
#include <hip/hip_runtime.h>
#include <cstdio>
#include <cstdint>
namespace pg8 {
#define PG8_LAS __attribute__((address_space(3)))
typedef unsigned short bf16_t;
typedef short bf16x8 __attribute__((ext_vector_type(8)));
typedef float f32x4 __attribute__((ext_vector_type(4)));
typedef unsigned u32x4 __attribute__((ext_vector_type(4)));
constexpr int BM = 256, BK = 64, HALF = 128, HTB = HALF * BK * 2  , STAGE_BYTES = 8 * HTB, NXCD = 8, WGM = 8;

__host__ __device__ __forceinline__ int lds_byte(int r, int c) { const int st = (r >> 4) * 2 + (c >> 5), rr = r & 15, cc = c & 31, ob = rr * 64 + cc * 2; return st * 1024 + (ob ^ (((ob >> 9) & 1) << 5)); }
__host__ __device__ __forceinline__ void stage_rc(int b, int& R, int& C) { const int st = b / 1024, sb = b % 1024, swz = sb ^ (((sb >> 9) & 1) << 5); R = (st >> 1) * 16 + swz / 64; C = (st & 1) * 32 + (swz % 64) / 2; }
__host__ __device__ __forceinline__ int perm32(int rho) { const int n = rho >> 4, i = rho & 15; return 8 * (i >> 2) + 4 * n + (i & 3); }

struct Unit { int pm, pn; };
struct Gemm { const bf16_t* A; const bf16_t* Bt; int M, N, K; };

struct StaticOrder {
    int nM, nN, nwg, G, c;
    __host__ __device__ void init(int M, int N, int G_, int c_) { nM = M / BM; nN = N / BM; nwg = nM * nN; G = G_; c = c_; }
    __host__ __device__ bool next(int i, Unit& u) const {
        const long L = (long)i * G + c; if (L >= nwg) return false;
        int wgid = (int)L; { const int q = nwg / NXCD, r = nwg % NXCD, xcd = wgid % NXCD, off = wgid / NXCD; wgid = (xcd < r ? xcd * (q + 1) : r * (q + 1) + (xcd - r) * q) + off; }
        const int nig = WGM * nN, gid = wgid / nig, fm = gid * WGM, gsz = (nM - fm) < WGM ? (nM - fm) : WGM;
        u.pm = fm + ((wgid % nig) % gsz); u.pn = (wgid % nig) / gsz; return true;
    }
    __device__ __forceinline__ void a_ready(const Unit&) const {}
    __device__ __forceinline__ void done(const Unit&) const {}
};

__device__ __forceinline__ unsigned cvt_pk_bf16(float lo, float hi) { unsigned r; asm volatile("v_cvt_pk_bf16_f32 %0, %1, %2" : "=v"(r) : "v"(lo), "v"(hi)); return r; }

constexpr int PPR = 4160, PPS = 4128, RPAD = 48;
struct EpiProj {
    static constexpr bool PERM = true, AFTER_DRAIN = false;
    bf16_t* O; int ldc; const float* rope_rev; bf16_t* KST; bf16_t* VT; bf16_t* SVT;
    static __device__ __forceinline__ unsigned short bf1(float f) { unsigned u = __builtin_bit_cast(unsigned, f); return (unsigned short)((u + 0x7fffu + ((u >> 16) & 1u)) >> 16); }
    static __device__ __forceinline__ void tstore(bf16_t* base, int H, int Dh, int PP, int hd, int d0, const float (&v)[8], int row, int col) {
        if (row < 16384) { bf16_t* ptr = base + ((size_t)((row >> 12) * H + hd) * Dh + d0) * PP + col;
#pragma unroll
            for (int e = 0; e < 8; ++e) ptr[(size_t)e * PP] = bf1(v[e]); }
        else if (row < 16400) {
#pragma unroll
            for (int b = 0; b < 4; ++b) { bf16_t* ptr = base + ((size_t)(b * H + hd) * Dh + d0) * PP + col;
#pragma unroll
                for (int e = 0; e < 8; ++e) ptr[(size_t)e * PP] = bf1(v[e]); } }
    }
    __device__ __forceinline__ void operator()(const f32x4 (&acc)[2][2][4][2], const Unit& u, int wr, int wc, int fr, int fq) const {
        const int row0 = u.pm * BM + wr * 64 + fr, cl = wc * 32 + 8 * fq, col0 = u.pn * BM + cl, pn = u.pn;
        if (pn < 16) {
            const f32x4 iv0 = *(const f32x4*)(rope_rev + cl), iv1 = *(const f32x4*)(rope_rev + cl + 4);
            const int h = pn & 7; const float lgh = __builtin_log2f(1.0f - __builtin_exp2f(-5.0f - (float)h));
#pragma unroll
            for (int ai = 0; ai < 2; ++ai)
#pragma unroll
                for (int m = 0; m < 4; ++m) {
                    const int row = row0 + ai * HALF + m * 16;
                    const int p = row < 16384 ? (row & 4095) + 16 : row - 16384;
                    const float pos = (float)p, ml = (float)((p + RPAD) & 63);
                    const float sc = pn < 8 ? 0.0625f * __builtin_exp2f(ml * lgh) : __builtin_exp2f(-ml * lgh);
                    bf16_t* rowp = O + (size_t)row * ldc + col0;
                    float o0[8], o1[8];
#pragma unroll
                    for (int n = 0; n < 2; ++n)
#pragma unroll
                        for (int j = 0; j < 4; ++j) {
                            float t = pos * (n ? iv1[j] : iv0[j]); t = t - floorf(t);
                            const float sn = __builtin_amdgcn_sinf(t), cs = __builtin_amdgcn_cosf(t);
                            const float x1 = acc[ai][0][m][n][j], x2 = acc[ai][1][m][n][j];
                            o0[n * 4 + j] = (x1 * cs - x2 * sn) * sc; o1[n * 4 + j] = (x1 * sn + x2 * cs) * sc;
                        }
                    u32x4 w; w.x = cvt_pk_bf16(o0[0], o0[1]); w.y = cvt_pk_bf16(o0[2], o0[3]); w.z = cvt_pk_bf16(o0[4], o0[5]); w.w = cvt_pk_bf16(o0[6], o0[7]);
                    *(u32x4*)(rowp) = w;
                    w.x = cvt_pk_bf16(o1[0], o1[1]); w.y = cvt_pk_bf16(o1[2], o1[3]); w.z = cvt_pk_bf16(o1[4], o1[5]); w.w = cvt_pk_bf16(o1[6], o1[7]);
                    *(u32x4*)(rowp + HALF) = w;
                    if (pn >= 8) { tstore(KST, 8, 256, PPR, h, cl, o0, row, p + RPAD); tstore(KST, 8, 256, PPR, h, HALF + cl, o1, row, p + RPAD); }
                }
        } else if (pn < 24 || pn >= 48) {
            const bool isr = pn < 24;
#pragma unroll
            for (int ai = 0; ai < 2; ++ai)
#pragma unroll
                for (int m = 0; m < 4; ++m) {
                    const int row = row0 + ai * HALF + m * 16;
                    const int p = row < 16384 ? (row & 4095) + 16 : row - 16384;
#pragma unroll
                    for (int bj = 0; bj < 2; ++bj) {
                        float v[8];
#pragma unroll
                        for (int n = 0; n < 2; ++n)
#pragma unroll
                            for (int j = 0; j < 4; ++j) v[n * 4 + j] = acc[ai][bj][m][n][j];
                        if (isr) tstore(VT, 8, 256, PPR, pn - 16, bj * HALF + cl, v, row, p + RPAD);
                        else tstore(SVT, 16, 128, PPS, 2 * (pn - 48) + bj, cl, v, row, p);
                    }
                }
        } else {
            const float sc = (pn >= 32 && pn < 40) ? 0.12751743082459868f : 1.0f;
#pragma unroll
            for (int ai = 0; ai < 2; ++ai)
#pragma unroll
                for (int m = 0; m < 4; ++m) { bf16_t* rowp = O + (size_t)(row0 + ai * HALF + m * 16) * ldc + col0;
#pragma unroll
                    for (int bj = 0; bj < 2; ++bj) { const f32x4 v0 = acc[ai][bj][m][0] * sc, v1 = acc[ai][bj][m][1] * sc;
                        u32x4 w; w.x = cvt_pk_bf16(v0[0], v0[1]); w.y = cvt_pk_bf16(v0[2], v0[3]); w.z = cvt_pk_bf16(v1[0], v1[1]); w.w = cvt_pk_bf16(v1[2], v1[3]);
                        *(u32x4*)(rowp + bj * HALF) = w; } }
        }
    }
};

struct EpiF32Split {
    static constexpr bool PERM = false, AFTER_DRAIN = false;
    float* C0; float* C1; int rows0; int ldc;
    __device__ __forceinline__ void operator()(const f32x4 (&acc)[2][2][4][2], const Unit& u, int wr, int wc, int fr, int fq) const {
        const int row0 = u.pm * BM + wr * 64 + fr, col0 = u.pn * BM + wc * 32 + 4 * fq;
        float* base = row0 < rows0 ? C0 + (size_t)row0 * ldc : C1 + (size_t)(row0 - rows0) * ldc;
#pragma unroll
        for (int ai = 0; ai < 2; ++ai)
#pragma unroll
            for (int m = 0; m < 4; ++m) { float* rowp = base + (size_t)(ai * HALF + m * 16) * ldc + col0;
#pragma unroll
                for (int bj = 0; bj < 2; ++bj)
#pragma unroll
                    for (int n = 0; n < 2; ++n) *(f32x4*)(rowp + bj * HALF + n * 16) = acc[ai][bj][m][n]; }
    }
};

struct EpiConv {
    static constexpr bool PERM = true, AFTER_DRAIN = false;
    bf16_t* ACT; float* HALO; float* FIRSTG; float* FIRSTU; const float* cw; const float* cb; int dff;
    __device__ __forceinline__ void operator()(const f32x4 (&acc)[2][2][4][2], const Unit& u, int wr, int wc, int fr, int fq) const {
        const int lane = fq * 16 + fr, j0 = u.pn * HALF + wc * 32 + 8 * fq;
        if (u.pm == 64) {
            if (wr == 0 && fr >= 14) { float* hp = HALO + ((size_t)256 * 2 + (fr - 14)) * dff + j0; *(f32x4*)hp = acc[0][0][0][0]; *(f32x4*)(hp + 4) = acc[0][0][0][1]; }
            return;
        }
        f32x4 w0[2], w1[2], w2[2], bb[2];
#pragma unroll
        for (int n = 0; n < 2; ++n) { w0[n] = *(const f32x4*)(cw + j0 + 4 * n); w1[n] = *(const f32x4*)(cw + dff + j0 + 4 * n); w2[n] = *(const f32x4*)(cw + 2 * dff + j0 + 4 * n); bb[n] = *(const f32x4*)(cb + j0 + 4 * n); }
        const int s1 = fr >= 1 ? lane - 1 : lane + 15, s2 = fr >= 2 ? lane - 2 : lane + 14;
#pragma unroll
        for (int ai = 0; ai < 2; ++ai) {
            const int sg = u.pm * 4 + ai * 2 + wr;
#pragma unroll
            for (int m = 0; m < 4; ++m) {
                const int row = u.pm * BM + ai * HALF + wr * 64 + m * 16 + fr;
                float o[8];
#pragma unroll
                for (int n = 0; n < 2; ++n)
#pragma unroll
                    for (int j = 0; j < 4; ++j) {
                        const float g = acc[ai][0][m][n][j], gp = m > 0 ? acc[ai][0][m > 0 ? m - 1 : 0][n][j] : 0.f;
                        const float snd1 = fr == 15 ? gp : g, snd2 = fr >= 14 ? gp : g;
                        const float x1 = __shfl(snd1, s1), x2 = __shfl(snd2, s2);
                        const float cv = bb[n][j] + w0[n][j] * x2 + w1[n][j] * x1 + w2[n][j] * g;
                        const float sl = cv * __builtin_amdgcn_rcpf(1.0f + __builtin_amdgcn_exp2f(-1.4426950408889634f * cv));
                        o[n * 4 + j] = sl * acc[ai][1][m][n][j];
                    }
                if (m == 0 && fr < 2) {
                    float* gpz = FIRSTG + ((size_t)sg * 2 + fr) * dff + j0; float* upz = FIRSTU + ((size_t)sg * 2 + fr) * dff + j0;
                    *(f32x4*)gpz = acc[ai][0][0][0]; *(f32x4*)(gpz + 4) = acc[ai][0][0][1]; *(f32x4*)upz = acc[ai][1][0][0]; *(f32x4*)(upz + 4) = acc[ai][1][0][1];
                } else {
                    u32x4 w; w.x = cvt_pk_bf16(o[0], o[1]); w.y = cvt_pk_bf16(o[2], o[3]); w.z = cvt_pk_bf16(o[4], o[5]); w.w = cvt_pk_bf16(o[6], o[7]);
                    *(u32x4*)(ACT + (size_t)row * dff + j0) = w;
                }
                if (m == 3 && fr >= 14) { float* hp = HALO + ((size_t)sg * 2 + (fr - 14)) * dff + j0; *(f32x4*)hp = acc[ai][0][3][0]; *(f32x4*)(hp + 4) = acc[ai][0][3][1]; }
            }
        }
    }
};

template <class Epi, class Sched, bool ALIGN_EPI = false, bool SP2 = false>
__device__ __forceinline__ void gemm_phase(PG8_LAS unsigned char* lds, const Gemm g, const Sched& S, const Epi& E) {
    const int tid = threadIdx.x, wid = __builtin_amdgcn_readfirstlane(tid >> 6), lane = tid & 63, wr = wid >> 2, wc = wid & 3, fr = lane & 15, fq = lane >> 4;
    const int K = g.K, nt = K / BK;
    unsigned voffA[2], voffB[2];
#pragma unroll
    for (int i = 0; i < 2; ++i) { int R, C; stage_rc(tid * 16 + i * 8192, R, C); const int Rb = Epi::PERM ? ((R & ~31) + perm32(R & 31)) : R;
        voffA[i] = (unsigned)(R * K + C) * 2u; voffB[i] = (unsigned)(Rb * K + C) * 2u; }
    const size_t kstep = (size_t)(BK * 2);
    const size_t hstep = (size_t)HALF * K * 2;
    const size_t tstep = 2 * hstep;
    const unsigned ldsw = (unsigned)wid * 1024u;
    const int aoff = lds_byte(wr * 64 + fr, fq * 8), boff = lds_byte(wc * 32 + fr, fq * 8);
#define PG8_SA(b, h) (((b) * 2 + (h)) * HTB)
#define PG8_SB(b, h) ((4 + (b) * 2 + (h)) * HTB)
#define PG8_STAGE(bufoff, gbase, voff) do { _Pragma("unroll") for (int _i = 0; _i < 2; ++_i) \
        __builtin_amdgcn_global_load_lds((const unsigned*)((const char*)(gbase) + (voff)[_i]), (PG8_LAS unsigned*)(lds + (bufoff) + ldsw + _i * 8192), 16, 0, 0); } while (0)
#define PG8_LDA(dst, b, h) do { _Pragma("unroll") for (int m = 0; m < 4; ++m) _Pragma("unroll") for (int k = 0; k < 2; ++k) dst[m][k] = *(const PG8_LAS bf16x8*)(lds + PG8_SA(b, h) + aoff + m * 2048 + k * 1024); } while (0)
#define PG8_LDB(dst, b, h) do { _Pragma("unroll") for (int n = 0; n < 2; ++n) _Pragma("unroll") for (int k = 0; k < 2; ++k) dst[n][k] = *(const PG8_LAS bf16x8*)(lds + PG8_SB(b, h) + boff + n * 2048 + k * 1024); } while (0)
#define PG8_MMA(ai, bj, At, Bt) do { __builtin_amdgcn_s_setprio(1); _Pragma("unroll") for (int m = 0; m < 4; ++m) _Pragma("unroll") for (int n = 0; n < 2; ++n) _Pragma("unroll") for (int k = 0; k < 2; ++k) \
        acc[ai][bj][m][n] = __builtin_amdgcn_mfma_f32_16x16x32_bf16(Bt[n][k], At[m][k], acc[ai][bj][m][n], 0, 0, 0); __builtin_amdgcn_s_setprio(0); } while (0)
#define PG8_WAIT_V(n) asm volatile("s_waitcnt vmcnt(" #n ")" ::: "memory")
#define PG8_WAIT_L(n) asm volatile("s_waitcnt lgkmcnt(" #n ")" ::: "memory")
#define PG8_BAR __builtin_amdgcn_s_barrier()
#define PG8_SCHED __builtin_amdgcn_sched_barrier(0)
    Unit cur, nxt; int ui = 0;
    if (!S.next(0, cur)) return;
    f32x4 acc[2][2][4][2];
#pragma unroll
    for (int a = 0; a < 2; ++a)
#pragma unroll
        for (int b = 0; b < 2; ++b)
#pragma unroll
            for (int m = 0; m < 4; ++m)
#pragma unroll
                for (int n = 0; n < 2; ++n) acc[a][b][m][n] = (f32x4){0.f, 0.f, 0.f, 0.f};
    bf16x8 At[4][2], B0[2][2], B1[2][2];
    const char* cA = (const char*)g.A + (size_t)cur.pm * tstep; const char* cB = (const char*)g.Bt + (size_t)cur.pn * tstep;
    S.a_ready(cur);
    if constexpr (SP2) {
        PG8_STAGE(PG8_SB(0, 0), cB, voffB); PG8_STAGE(PG8_SB(0, 1), cB + hstep, voffB); PG8_STAGE(PG8_SA(0, 0), cA, voffA); PG8_STAGE(PG8_SA(0, 1), cA + hstep, voffA);
        if (wr == 1) PG8_BAR;
        PG8_WAIT_V(2); PG8_BAR;
        PG8_STAGE(PG8_SB(1, 0), cB + kstep, voffB); PG8_STAGE(PG8_SA(1, 0), cA + kstep, voffA); PG8_STAGE(PG8_SB(1, 1), cB + hstep + kstep, voffB);
        PG8_WAIT_V(6); PG8_BAR;
    } else {
        PG8_STAGE(PG8_SB(0, 0), cB, voffB); PG8_STAGE(PG8_SA(0, 0), cA, voffA); PG8_STAGE(PG8_SB(0, 1), cB + hstep, voffB); PG8_STAGE(PG8_SA(0, 1), cA + hstep, voffA);
        if (wr == 1) PG8_BAR;
        PG8_WAIT_V(4); PG8_BAR;
        PG8_STAGE(PG8_SB(1, 0), cB + kstep, voffB); PG8_STAGE(PG8_SA(1, 0), cA + kstep, voffA); PG8_STAGE(PG8_SB(1, 1), cB + hstep + kstep, voffB);
        PG8_WAIT_V(6); PG8_BAR;
    }
    for (;;) {
        const bool has_next = S.next(ui + 1, nxt);
        const char* nA = has_next ? (const char*)g.A + (size_t)nxt.pm * tstep : cA; const char* nB = has_next ? (const char*)g.Bt + (size_t)nxt.pn * tstep : cB;
        for (int t = 0; t < nt; t += 2) {
            const bool last = (t == nt - 2);
            const char* a1 = cA + (size_t)(t + 1) * kstep;
            const char* a2 = last ? nA : cA + (size_t)(t + 2) * kstep; const char* b2 = last ? nB : cB + (size_t)(t + 2) * kstep;
            const char* a3 = a2 + kstep; const char* b3 = b2 + kstep;
            if (last && has_next) S.a_ready(nxt);
            if constexpr (SP2) {
            PG8_LDB(B0, 0, 0); PG8_LDB(B1, 0, 1); PG8_SCHED; PG8_LDA(At, 0, 0); PG8_STAGE(PG8_SA(1, 1), a1 + hstep, voffA);
            PG8_WAIT_V(8); PG8_WAIT_L(0); PG8_BAR; PG8_MMA(0, 0, At, B0); PG8_MMA(0, 1, At, B1); PG8_BAR; PG8_SCHED;
            PG8_LDA(At, 0, 1); PG8_STAGE(PG8_SB(0, 0), b2, voffB); PG8_STAGE(PG8_SB(0, 1), b2 + hstep, voffB); PG8_STAGE(PG8_SA(0, 0), a2, voffA);
            PG8_WAIT_V(8); PG8_WAIT_L(0); PG8_BAR; PG8_MMA(1, 0, At, B0); PG8_MMA(1, 1, At, B1); PG8_BAR; PG8_SCHED;
            PG8_LDB(B0, 1, 0); PG8_LDB(B1, 1, 1); PG8_SCHED; PG8_LDA(At, 1, 0); PG8_STAGE(PG8_SA(0, 1), a2 + hstep, voffA);
            PG8_WAIT_V(8); PG8_WAIT_L(0); PG8_BAR; PG8_MMA(0, 0, At, B0); PG8_MMA(0, 1, At, B1); PG8_BAR; PG8_SCHED;
            PG8_LDA(At, 1, 1); PG8_STAGE(PG8_SB(1, 0), b3, voffB); PG8_STAGE(PG8_SB(1, 1), b3 + hstep, voffB); PG8_STAGE(PG8_SA(1, 0), a3, voffA);
            PG8_WAIT_V(8); PG8_WAIT_L(0); PG8_BAR; PG8_MMA(1, 0, At, B0); PG8_MMA(1, 1, At, B1); PG8_BAR; PG8_SCHED;
            } else {
            PG8_LDB(B0, 0, 0); PG8_SCHED; PG8_LDA(At, 0, 0); PG8_STAGE(PG8_SA(1, 1), a1 + hstep, voffA);
            PG8_WAIT_L(8); PG8_BAR; PG8_WAIT_L(0); PG8_MMA(0, 0, At, B0); PG8_BAR; PG8_SCHED;
            PG8_LDB(B1, 0, 1); PG8_STAGE(PG8_SB(0, 0), b2, voffB);
            PG8_BAR; PG8_WAIT_L(0); PG8_MMA(0, 1, At, B1); PG8_BAR;
            PG8_LDA(At, 0, 1); PG8_STAGE(PG8_SA(0, 0), a2, voffA);
            PG8_BAR; PG8_WAIT_L(0); PG8_MMA(1, 0, At, B0); PG8_BAR; PG8_SCHED;
            PG8_STAGE(PG8_SB(0, 1), b2 + hstep, voffB);
            PG8_WAIT_V(6); PG8_BAR; PG8_MMA(1, 1, At, B1); PG8_BAR;
            PG8_LDB(B0, 1, 0); PG8_SCHED; PG8_LDA(At, 1, 0); PG8_STAGE(PG8_SA(0, 1), a2 + hstep, voffA);
            PG8_WAIT_L(8); PG8_BAR; PG8_WAIT_L(0); PG8_MMA(0, 0, At, B0); PG8_BAR; PG8_SCHED;
            PG8_LDB(B1, 1, 1); PG8_STAGE(PG8_SB(1, 0), b3, voffB);
            PG8_BAR; PG8_WAIT_L(0); PG8_MMA(0, 1, At, B1); PG8_BAR;
            PG8_LDA(At, 1, 1); PG8_STAGE(PG8_SA(1, 0), a3, voffA);
            PG8_BAR; PG8_WAIT_L(0); PG8_MMA(1, 0, At, B0); PG8_BAR; PG8_SCHED;
            PG8_STAGE(PG8_SB(1, 1), b3 + hstep, voffB);
            PG8_WAIT_V(6); PG8_BAR; PG8_MMA(1, 1, At, B1); PG8_BAR;
            }
        }
        if constexpr (ALIGN_EPI) { if (wr == 0) PG8_BAR; }
        if constexpr (!Epi::AFTER_DRAIN) { E(acc, cur, wr, wc, fr, fq); S.done(cur); }
        if (!has_next) break;
#pragma unroll
        for (int a = 0; a < 2; ++a)
#pragma unroll
            for (int b = 0; b < 2; ++b)
#pragma unroll
                for (int m = 0; m < 4; ++m)
#pragma unroll
                    for (int n = 0; n < 2; ++n) acc[a][b][m][n] = (f32x4){0.f, 0.f, 0.f, 0.f};
        cur = nxt; cA = nA; cB = nB; ++ui;
        if constexpr (ALIGN_EPI) { if (wr == 1) PG8_BAR; }
    }
    PG8_WAIT_V(0);
    if constexpr (!ALIGN_EPI) { if (wr == 0) PG8_BAR; }
    PG8_BAR;
    if constexpr (Epi::AFTER_DRAIN) { E.fused(acc, cur, wr, wc, fr, fq, lds, wid, lane); S.done(cur); }
#undef PG8_SA
#undef PG8_SB
#undef PG8_STAGE
#undef PG8_LDA
#undef PG8_LDB
#undef PG8_MMA
#undef PG8_WAIT_V
#undef PG8_WAIT_L
#undef PG8_BAR
#undef PG8_SCHED
}
}

#ifndef PG8_SP2
#define PG8_SP2 true
#endif
#ifndef PG8_ALIGN
#define PG8_ALIGN true
#endif
#ifndef MK_N_LAUNCHES
#define MK_N_LAUNCHES 1
#endif
constexpr int N_LAUNCHES = MK_N_LAUNCHES;
constexpr int N_PHASES = 10;

constexpr int NWAVES = 8;
constexpr int D = 4096, NB = 4, SEQ = 4096, NMETA = 16;
constexpr int MSEQ = NB * SEQ;
constexpr int MROWS = MSEQ + NMETA;
constexpr int MPAD = 65 * 256;
constexpr int IN_COLS = 14336, DFF = 11008, NUP = 2 * DFF;
constexpr int RET_H = 8, SB_H = 16;
constexpr int C_RQ = 0, C_RK = 2048, C_RV = 4096, C_RG = 6144, C_SQ = 8192, C_SK = 10240, C_SV = 12288;
constexpr float EPS = 1e-6f;

constexpr size_t MiB = 1u << 20;
constexpr size_t WS_CTL = 0, CTL_ZERO_BYTES = 1 * MiB;
constexpr size_t WS_WIN = 1 * MiB;
constexpr size_t WS_WOUT = WS_WIN + (size_t)IN_COLS * D * 2;
constexpr size_t WS_WUP = WS_WOUT + (size_t)D * D * 2;
constexpr size_t WS_WDOWN = WS_WUP + (size_t)NUP * D * 2;
constexpr size_t WS_XN = WS_WDOWN + (size_t)D * DFF * 2;
constexpr size_t WS_PROJ = WS_XN + (size_t)MPAD * D * 2;
constexpr size_t WS_ACT = WS_PROJ;
constexpr size_t WS_META = WS_PROJ + (size_t)MPAD * IN_COLS * 2;
constexpr size_t WS_HALO = WS_META + (size_t)256 * D * 4;
constexpr size_t WS_FIRSTG = WS_HALO + (size_t)257 * 2 * DFF * 4;
constexpr size_t WS_FIRSTU = WS_FIRSTG + (size_t)256 * 2 * DFF * 4;
constexpr size_t WS_KST = WS_FIRSTU + (size_t)256 * 2 * DFF * 4;
constexpr size_t WS_VT = WS_KST + (size_t)NB * RET_H * 256 * pg8::PPR * 2;
constexpr size_t WS_SVT = WS_VT + (size_t)NB * RET_H * 256 * pg8::PPR * 2;
constexpr size_t WS_END = WS_SVT + (size_t)NB * SB_H * 128 * pg8::PPS * 2;
constexpr size_t WS_F = WS_WIN;
static_assert(WS_F + (size_t)MSEQ * D * 4 <= WS_WDOWN, "F overlay must not reach the w_down copy");
static_assert(WS_ACT + (size_t)MSEQ * DFF * 2 <= WS_META, "ACT overlay inside PROJ");
constexpr int CW_TMO = 0, CW_CODE = 1, CW_BAR = 4096;

constexpr int RING_OFF = 0, RING_BYTES = 131072;
constexpr int LDSCTL_OFF = RING_BYTES, MISC_OFF = LDSCTL_OFF + 320;
constexpr int LDS_BYTES = 147456;
static_assert(MISC_OFF + 128 <= LDS_BYTES, "LDS map");

#define GAS __attribute__((address_space(1)))
#define LAS __attribute__((address_space(3)))
typedef unsigned short bf16;
typedef unsigned v4u __attribute__((ext_vector_type(4)));
typedef unsigned v2u __attribute__((ext_vector_type(2)));
typedef float f32x4 __attribute__((ext_vector_type(4)));
typedef short bf16x8 __attribute__((ext_vector_type(8)));
typedef GAS unsigned gu32;
#define RLX_AGENT __ATOMIC_RELAXED, __HIP_MEMORY_SCOPE_AGENT
#define LDS_WAIT() asm volatile("s_waitcnt lgkmcnt(0)" ::: "memory")
#define VM_WAIT() asm volatile("s_waitcnt vmcnt(0)" ::: "memory")
__device__ __forceinline__ unsigned f2bf(float f) { unsigned u = __builtin_bit_cast(unsigned, f); return (u + 0x7fffu + ((u >> 16) & 1u)) >> 16; }
__device__ __forceinline__ unsigned pk2(float lo, float hi) { return f2bf(lo) | (f2bf(hi) << 16); }
__device__ __forceinline__ float bflo(unsigned w) { return __builtin_bit_cast(float, w << 16); }
__device__ __forceinline__ float bfhi(unsigned w) { return __builtin_bit_cast(float, w & 0xffff0000u); }

__device__ const float ROPE_REV[128] = {1.591549367e-01f, 1.481051445e-01f, 1.378225088e-01f, 1.282537580e-01f, 1.193493754e-01f, 1.110631898e-01f, 1.033523008e-01f, 9.617675841e-02f, 8.949939907e-02f, 8.328563720e-02f, 7.750329375e-02f, 7.212239504e-02f, 6.711508334e-02f, 6.245541945e-02f, 5.811926723e-02f, 5.408416688e-02f, 5.032921210e-02f, 4.683495313e-02f, 4.358330369e-02f, 4.055740312e-02f, 3.774158657e-02f, 3.512126580e-02f, 3.268286586e-02f, 3.041376360e-02f, 2.830219641e-02f, 2.633723244e-02f, 2.450869232e-02f, 2.280710265e-02f, 2.122365125e-02f, 1.975013874e-02f, 1.837892644e-02f, 1.710291393e-02f, 1.591549441e-02f, 1.481051464e-02f, 1.378224976e-02f, 1.282537542e-02f, 1.193493605e-02f, 1.110631879e-02f, 1.033523027e-02f, 9.617676027e-03f, 8.949940093e-03f, 8.328564465e-03f, 7.750329096e-03f, 7.212239318e-03f, 6.711508613e-03f, 6.245541386e-03f, 5.811926443e-03f, 5.408416502e-03f, 5.032920744e-03f, 4.683495499e-03f, 4.358330276e-03f, 4.055740312e-03f, 3.774158657e-03f, 3.512126161e-03f, 3.268286819e-03f, 3.041375894e-03f, 2.830219688e-03f, 2.633722965e-03f, 2.450869186e-03f, 2.280710265e-03f, 2.122365404e-03f, 1.975013874e-03f, 1.837892691e-03f, 1.710291486e-03f, 1.591549371e-03f, 1.481051324e-03f, 1.378225046e-03f, 1.282537705e-03f, 1.193493721e-03f, 1.110631856e-03f, 1.033522887e-03f, 9.617675678e-04f, 8.949940093e-04f, 8.328563999e-04f, 7.750329096e-04f, 7.212238852e-04f, 6.711508031e-04f, 6.245541736e-04f, 5.811926676e-04f, 5.408416619e-04f, 5.032921326e-04f, 4.683495790e-04f, 4.358330334e-04f, 4.055740428e-04f, 3.774158249e-04f, 3.512126568e-04f, 3.268286237e-04f, 3.041376185e-04f, 2.830219746e-04f, 2.633723198e-04f, 2.450869069e-04f, 2.280710323e-04f, 2.122365258e-04f, 1.975013729e-04f, 1.837892487e-04f, 1.710291544e-04f, 1.591549517e-04f, 1.481051440e-04f, 1.378224988e-04f, 1.282537705e-04f, 1.193493736e-04f, 1.110631856e-04f, 1.033523004e-04f, 9.617675823e-05f, 8.949940093e-05f, 8.328563854e-05f, 7.750328950e-05f, 7.212239143e-05f, 6.711508468e-05f, 6.245541590e-05f, 5.811926894e-05f, 5.408416473e-05f, 5.032921035e-05f, 4.683495354e-05f, 4.358330261e-05f, 4.055740283e-05f, 3.774158540e-05f, 3.512126204e-05f, 3.268286673e-05f, 3.041376112e-05f, 2.830219637e-05f, 2.633723307e-05f, 2.450869033e-05f, 2.280710214e-05f, 2.122365368e-05f, 1.975013765e-05f, 1.837892705e-05f, 1.710291508e-05f};


#define XB_TMO      128
#define XB_XCNT(j)  (256  + 64 * (j))
#define XB_XSUB(j)  (1280 + 64 * (j))
#define XB_XGEN(j)  (2304 + 64 * (j))
#define XB_TOP      3328
#define XB_TOPGEN   3392
#define XCD_BAR_WORDS 3456
#define XB_SPIN_CAP (1u << 22)

__device__ __forceinline__ unsigned xb_ld(unsigned* p)              { return __hip_atomic_load(p, __ATOMIC_RELAXED, __HIP_MEMORY_SCOPE_AGENT); }
__device__ __forceinline__ unsigned xb_add(unsigned* p, unsigned v) { return __hip_atomic_fetch_add(p, v, __ATOMIC_RELAXED, __HIP_MEMORY_SCOPE_AGENT); }
__device__ __forceinline__ unsigned xb_xcc_id() { return (unsigned)__builtin_amdgcn_s_getreg((3 << 11) | 20) & 0xFu; }
#define XB_SPIN(cond, bar) do { unsigned _sp = 0; while (cond) { __builtin_amdgcn_s_sleep(1); \
    if ((++_sp & 255u) == 0u) { if (xb_ld(&(bar)[XB_TMO])) break; if (_sp > XB_SPIN_CAP) { atomicAdd(&(bar)[XB_TMO], 1u); break; } } } } while (0)

struct XcdBarrier {
    unsigned* bar; unsigned x;
    volatile LAS unsigned* st;
};

__device__ __forceinline__ XcdBarrier xcd_barrier_post(unsigned* bar, volatile LAS unsigned* st) {
    XcdBarrier b; b.bar = bar; b.x = xb_xcc_id(); b.st = st;
    if (threadIdx.x == 0) (void)xb_add(&bar[XB_XCNT(b.x)], 1u);
    return b;
}
__device__ __forceinline__ void xcd_barrier_complete(unsigned* bar, unsigned x, unsigned& nloc, unsigned& nx) {
    const unsigned G = gridDim.x * gridDim.y * gridDim.z;
    unsigned sum, cnt, mine, sp = 0u;
    for (;;) {
        sum = 0u; cnt = 0u; mine = 0u;
#pragma unroll
        for (unsigned j = 0; j < 16; ++j) { const unsigned c = xb_ld(&bar[XB_XCNT(j)]); sum += c; cnt += (c > 0u) ? 1u : 0u; mine = (j == x) ? c : mine; }
        if (sum == G) break;
        __builtin_amdgcn_s_sleep(1);
        if ((++sp & 255u) == 0u) { if (xb_ld(&bar[XB_TMO])) break; if (sp > XB_SPIN_CAP) { atomicAdd(&bar[XB_TMO], 1u); break; } }
    }
    nloc = mine > 0u ? mine : 1u; nx = cnt > 0u ? cnt : 1u;
}

__device__ __forceinline__ void xcd_barrier(const XcdBarrier& b) {
    asm volatile("s_waitcnt vmcnt(0)" ::: "memory");
    __syncthreads();
    if (threadIdx.x == 0) {
        unsigned* bar = b.bar;
        __builtin_amdgcn_s_waitcnt(0);
        unsigned nloc = b.st[0], nx = b.st[1];
        if (nloc == 0u) { xcd_barrier_complete(bar, b.x, nloc, nx); b.st[0] = nloc; b.st[1] = nx; }
        const unsigned old = xb_add(&bar[XB_XSUB(b.x)], 1u);
        const unsigned gen = old / nloc;
        if (old + 1u == (gen + 1u) * nloc) {
            __builtin_amdgcn_fence(__ATOMIC_RELEASE, "agent");
            asm volatile("s_waitcnt vmcnt(0)" ::: "memory");
            const unsigned og = xb_add(&bar[XB_TOP], 1u);
            const unsigned tg = og / nx;
            if (og + 1u == (tg + 1u) * nx) xb_add(&bar[XB_TOPGEN], 1u);
            else XB_SPIN(xb_ld(&bar[XB_TOPGEN]) == tg, bar);
            __builtin_amdgcn_fence(__ATOMIC_ACQUIRE, "agent");
            xb_add(&bar[XB_XGEN(b.x)], 1u);
            asm volatile("s_waitcnt vmcnt(0)" ::: "memory");
        } else {
            XB_SPIN(xb_ld(&bar[XB_XGEN(b.x)]) == gen, bar);
            __builtin_amdgcn_fence(__ATOMIC_ACQUIRE, "agent");
            asm volatile("s_waitcnt vmcnt(0)" ::: "memory");
        }
    }
    __syncthreads();
}


struct Frame {
    LAS unsigned char* lds;
    volatile LAS unsigned* MISC;
    gu32* ctl;
    int tid, lane, wave, vcu, G;
    const float *x, *meta, *w_pre, *w_in, *gn_w, *sbn_w, *w_out, *w_post, *w_pre2, *w_up, *conv_w, *conv_b, *w_down, *w_post2;
    float* out;
    bf16 *WIN, *WOUT, *WUP, *WDOWN, *XN, *PROJ, *ACT, *KST, *VT, *SVT;
    float *META, *HALO, *FIRSTG, *FIRSTU, *Fb;
};
__device__ __forceinline__ float wave_sum(float v) {
#pragma unroll
    for (int o = 1; o < 64; o <<= 1) v += __shfl_xor(v, o);
    return v;
}
__device__ __forceinline__ void p0_transpose_item(const float* W, int K, int N, bf16* WT, int k0, int n0, int dst0, LAS float* scr, int lane) {
#pragma unroll 8
    for (int i = 0; i < 32; ++i) { const int kk = 2 * i + (lane >> 5); scr[kk * 33 + (lane & 31)] = W[(size_t)(k0 + kk) * N + n0 + (lane & 31)]; }
    LDS_WAIT(); asm volatile("" ::: "memory");
    const int c = lane & 7;
#pragma unroll
    for (int j = 0; j < 4; ++j) { const int n = (lane >> 3) + 8 * j; const LAS float* s = scr + (8 * c) * 33 + n;
        v4u o; o.x = pk2(s[0 * 33], s[1 * 33]); o.y = pk2(s[2 * 33], s[3 * 33]); o.z = pk2(s[4 * 33], s[5 * 33]); o.w = pk2(s[6 * 33], s[7 * 33]);
        *(GAS v4u*)(WT + (size_t)(dst0 + n) * K + k0 + 8 * c) = o; }
    LDS_WAIT(); asm volatile("" ::: "memory");
}
__device__ __forceinline__ const float* h_row(Frame& F, int r) { return r < MSEQ ? F.x + (size_t)r * D : F.meta + (size_t)(r - MSEQ) * D; }

__device__ __forceinline__ void p0_prologue(Frame& F) {
    LAS float* scr = (LAS float*)(F.lds + RING_OFF + F.wave * 16384);
    const int gw = F.vcu * NWAVES + F.wave, NGW = F.G * NWAVES;
    constexpr int I_IN = (D / 64) * (IN_COLS / 32), I_OUT = (D / 64) * (D / 32), I_UP = (D / 64) * (NUP / 32), I_DN = (DFF / 64) * (D / 32);
    constexpr int NITEMS = I_IN + I_OUT + I_UP + I_DN;
    for (int it = gw; it < NITEMS; it += NGW) {
        int r = it;
        if (r < I_IN) { const int nb = IN_COLS / 32, kb = r / nb, n0 = 32 * (r % nb); p0_transpose_item(F.w_in, D, IN_COLS, F.WIN, 64 * kb, n0, n0, scr, F.lane); continue; } r -= I_IN;
        if (r < I_OUT) { const int nb = D / 32, kb = r / nb, n0 = 32 * (r % nb); p0_transpose_item(F.w_out, D, D, F.WOUT, 64 * kb, n0, n0, scr, F.lane); continue; } r -= I_OUT;
        if (r < I_UP) { const int nb = NUP / 32, kb = r / nb, n0 = 32 * (r % nb); const int up = n0 >= DFF, j = up ? n0 - DFF : n0;
            p0_transpose_item(F.w_up, D, NUP, F.WUP, 64 * kb, n0, (j >> 7) * 256 + up * 128 + (j & 127), scr, F.lane); continue; } r -= I_UP;
        { const int nb = D / 32, kb = r / nb, n0 = 32 * (r % nb); p0_transpose_item(F.w_down, DFF, D, F.WDOWN, 64 * kb, n0, n0, scr, F.lane); }
    }
    { const int gt = F.vcu * (NWAVES * 64) + F.tid, NGT = F.G * NWAVES * 64; constexpr int NR = NB * RET_H * 256;
        for (int i = gt; i < NR * 6; i += NGT) { const int r = i / 6, q = i % 6; const v4u z = {0u, 0u, 0u, 0u};
            *(GAS v4u*)(F.KST + (size_t)r * pg8::PPR + 8 * q) = z; *(GAS v4u*)(F.VT + (size_t)r * pg8::PPR + 8 * q) = z; }
        for (int i = gt; i < NR * 2; i += NGT) { const int r = i >> 1, q = i & 1; const v4u z = {0u, 0u, 0u, 0u}; *(GAS v4u*)(F.SVT + (size_t)r * pg8::PPS + 4112 + 8 * q) = z; } }
    for (int m = gw; m < MROWS; m += NGW) {
        const GAS f32x4* xr = (const GAS f32x4*)h_row(F, m) + F.lane; const GAS f32x4* wr4 = (const GAS f32x4*)F.w_pre + F.lane;
        f32x4 v[16]; float s = 0.f;
#pragma unroll
        for (int j = 0; j < 16; ++j) { v[j] = xr[64 * j]; s += (v[j].x * v[j].x + v[j].y * v[j].y) + (v[j].z * v[j].z + v[j].w * v[j].w); }
        const float r = 1.0f / sqrtf(wave_sum(s) * (1.f / D) + EPS);
        GAS v2u* o8 = (GAS v2u*)(F.XN + (size_t)m * D) + F.lane;
#pragma unroll
        for (int j = 0; j < 16; ++j) { const f32x4 w = wr4[64 * j]; v2u o; o.x = pk2(v[j].x * r * w.x, v[j].y * r * w.y); o.y = pk2(v[j].z * r * w.z, v[j].w * r * w.w); o8[64 * j] = o; }
    }
}

__device__ __forceinline__ size_t pos_row(int b, int p) { return p < NMETA ? (size_t)(MSEQ + p) : (size_t)(b * SEQ + p - NMETA); }

typedef float f32x16 __attribute__((ext_vector_type(16)));
typedef short s16x4 __attribute__((ext_vector_type(4)));
__device__ __forceinline__ unsigned cvtpk(float lo, float hi) { unsigned r; asm volatile("v_cvt_pk_bf16_f32 %0, %1, %2" : "=v"(r) : "v"(lo), "v"(hi)); return r; }
__device__ __forceinline__ bf16x8 pack8(float a0, float a1, float a2, float a3, float a4, float a5, float a6, float a7) {
    v4u w; w.x = cvtpk(a0, a1); w.y = cvtpk(a2, a3); w.z = cvtpk(a4, a5); w.w = cvtpk(a6, a7); return __builtin_bit_cast(bf16x8, w); }
__device__ __forceinline__ bf16x8 cat8(v2u lo, v2u hi) { v4u w; w.x = lo.x; w.y = lo.y; w.z = hi.x; w.w = hi.y; return __builtin_bit_cast(bf16x8, w); }

__device__ __forceinline__ void ret_unit(Frame& F, int b, int h, int sl) {
    const int lane = F.lane, li = lane & 15, g = lane >> 4;
    const bf16* KT = F.KST + (size_t)(b * RET_H + h) * 256 * pg8::PPR;
    const bf16* VTs = F.VT + ((size_t)(b * RET_H + h) * 256 + sl * 16 + li) * pg8::PPR;
    const float lgh = __builtin_log2f(1.0f - __builtin_exp2f(-5.0f - (float)h)), cdec = __builtin_exp2f(64.0f * lgh);
    f32x4 St[16];
#pragma unroll
    for (int i = 0; i < 16; ++i) St[i] = (f32x4){0.f, 0.f, 0.f, 0.f};
    for (int c = 0; c < 65; ++c) {
        const int pp0 = 64 * c;
        const bf16* rowp[4];
#pragma unroll
        for (int k = 0; k < 4; ++k) { int p = pp0 + 16 * k + li - pg8::RPAD; p = p < 0 ? 0 : p; rowp[k] = F.PROJ + pos_row(b, p) * IN_COLS + h * 256 + 4 * g; }
        f32x4 ST[10];
#pragma unroll
        for (int i = 0; i < 10; ++i) ST[i] = (f32x4){0.f, 0.f, 0.f, 0.f};
        f32x4 OT[4];
#pragma unroll
        for (int i = 0; i < 4; ++i) OT[i] = (f32x4){0.f, 0.f, 0.f, 0.f};
#pragma unroll
        for (int s = 0; s < 8; ++s) {
            bf16x8 Qf[4], Kf[4];
#pragma unroll
            for (int k = 0; k < 4; ++k) {
                Qf[k] = cat8(*(const GAS v2u*)(rowp[k] + C_RQ + 32 * s), *(const GAS v2u*)(rowp[k] + C_RQ + 32 * s + 16));
                Kf[k] = cat8(*(const GAS v2u*)(rowp[k] + C_RK + 32 * s), *(const GAS v2u*)(rowp[k] + C_RK + 32 * s + 16));
            }
            const bf16x8 SA = pack8(St[2 * s][0], St[2 * s][1], St[2 * s][2], St[2 * s][3], St[2 * s + 1][0], St[2 * s + 1][1], St[2 * s + 1][2], St[2 * s + 1][3]);
#pragma unroll
            for (int nb = 0; nb < 4; ++nb) {
#pragma unroll
                for (int mb = 0; mb <= nb; ++mb) ST[nb * (nb + 1) / 2 + mb] = __builtin_amdgcn_mfma_f32_16x16x32_bf16(Kf[mb], Qf[nb], ST[nb * (nb + 1) / 2 + mb], 0, 0, 0);
                OT[nb] = __builtin_amdgcn_mfma_f32_16x16x32_bf16(SA, Qf[nb], OT[nb], 0, 0, 0);
            }
        }
#pragma unroll
        for (int nb = 0; nb < 4; ++nb)
#pragma unroll
            for (int r = 0; r < 4; ++r) if (4 * g + r > li) ST[nb * (nb + 1) / 2 + nb][r] = 0.f;
#pragma unroll
        for (int sp = 0; sp < 2; ++sp) {
            const bf16x8 Vf = cat8(*(const GAS v2u*)(VTs + pp0 + 32 * sp + 4 * g), *(const GAS v2u*)(VTs + pp0 + 32 * sp + 16 + 4 * g));
#pragma unroll
            for (int nb = 2 * sp; nb < 4; ++nb) {
                const f32x4 lo = ST[nb * (nb + 1) / 2 + 2 * sp];
                f32x4 hi = (f32x4){0.f, 0.f, 0.f, 0.f}; if (2 * sp + 1 <= nb) hi = ST[nb * (nb + 1) / 2 + 2 * sp + 1];
                const bf16x8 Pf = pack8(lo[0], lo[1], lo[2], lo[3], hi[0], hi[1], hi[2], hi[3]);
                OT[nb] = __builtin_amdgcn_mfma_f32_16x16x32_bf16(Vf, Pf, OT[nb], 0, 0, 0);
            }
        }
#pragma unroll
        for (int nb = 0; nb < 4; ++nb) {
            const int p = pp0 + 16 * nb + li - pg8::RPAD;
            if (p >= NMETA || (p >= 0 && b == 0)) { v2u o; o.x = cvtpk(OT[nb][0], OT[nb][1]); o.y = cvtpk(OT[nb][2], OT[nb][3]);
                *(GAS v2u*)(F.XN + pos_row(b, p) * D + h * 256 + sl * 16 + 4 * g) = o; }
        }
        const bf16x8 Vn0 = *(const GAS bf16x8*)(VTs + pp0 + 8 * g), Vn1 = *(const GAS bf16x8*)(VTs + pp0 + 32 + 8 * g);
#pragma unroll
        for (int db = 0; db < 16; ++db) {
            const bf16* kt = KT + (size_t)(16 * db + li) * pg8::PPR + pp0 + 8 * g;
            const bf16x8 K0 = *(const GAS bf16x8*)(kt), K1 = *(const GAS bf16x8*)(kt + 32);
            St[db] = __builtin_amdgcn_mfma_f32_16x16x32_bf16(K0, Vn0, St[db], 0, 0, 0);
            St[db] = __builtin_amdgcn_mfma_f32_16x16x32_bf16(K1, Vn1, St[db], 0, 0, 0);
            St[db] = St[db] * cdec;
        }
    }
}

__device__ __forceinline__ void sb_unit(Frame& F, int b, int hd, int i) {
    const int lane = F.lane, r32 = lane & 31, hh = lane >> 5;
    const int pq = 32 * i + r32; const bool qvalid = pq < SEQ + NMETA;
    const bf16* qrow = F.PROJ + pos_row(b, qvalid ? pq : SEQ + NMETA - 1) * IN_COLS + C_SQ + hd * 128 + 8 * hh;
    bf16x8 qf[8];
#pragma unroll
    for (int kk = 0; kk < 8; ++kk) qf[kk] = *(const GAS bf16x8*)(qrow + 16 * kk);
    f32x16 o[4];
#pragma unroll
    for (int c = 0; c < 4; ++c)
#pragma unroll
        for (int r = 0; r < 16; ++r) o[c][r] = 0.f;
    float R = 0.f;
    const bf16* svt = F.SVT + ((size_t)(b * SB_H + hd) * 128 + r32) * pg8::PPS + 8 * hh;
    const int kperm = (r32 & ~12) | ((r32 & 4) << 1) | ((r32 & 8) >> 1);
    for (int kb = i; kb >= 0; --kb) {
        const int pk = 32 * kb + kperm;
        const bf16* krow = F.PROJ + pos_row(b, pk < SEQ + NMETA ? pk : SEQ + NMETA - 1) * IN_COLS + C_SK + hd * 128 + 8 * hh;
        bf16x8 kf[8], vf[8];
#pragma unroll
        for (int kk = 0; kk < 8; ++kk) kf[kk] = *(const GAS bf16x8*)(krow + 16 * kk);
#pragma unroll
        for (int c = 0; c < 4; ++c)
#pragma unroll
            for (int ks = 0; ks < 2; ++ks) vf[c * 2 + ks] = *(const GAS bf16x8*)(svt + (size_t)(32 * c) * pg8::PPS + 32 * kb + 16 * ks);
        f32x16 sacc;
#pragma unroll
        for (int r = 0; r < 16; ++r) sacc[r] = 0.f;
#pragma unroll
        for (int kk = 0; kk < 8; ++kk) sacc = __builtin_amdgcn_mfma_f32_32x32x16_bf16(kf[kk], qf[kk], sacc, 0, 0, 0);
        float lk[16], zb[16]; bool vm[16];
#pragma unroll
        for (int r = 0; r < 16; ++r) {
            const float z = sacc[r];
            const float sp = fmaxf(z, 0.f) + __builtin_amdgcn_logf(1.0f + __builtin_amdgcn_exp2f(-fabsf(z)));
            vm[r] = (kb < i) || (16 * (r >> 3) + 8 * hh + (r & 7) < r32);
            lk[r] = vm[r] ? -sp : 0.f; zb[r] = z - sp;
        }
        float ghi = 0.f, glo = 0.f;
#pragma unroll
        for (int r = 0; r < 8; ++r) { glo += lk[r]; ghi += lk[8 + r]; }
        const float pghi = __shfl_xor(ghi, 32), pglo = __shfl_xor(glo, 32);
        const float Thi = ghi + pghi, Tlo = glo + pglo;
        float w[16];
        float run = R + (hh ? 0.f : pghi);
#pragma unroll
        for (int r = 15; r >= 8; --r) { w[r] = vm[r] ? __builtin_amdgcn_exp2f(zb[r] + run) : 0.f; run += lk[r]; }
        run = (R + Thi) + (hh ? 0.f : pglo);
#pragma unroll
        for (int r = 7; r >= 0; --r) { w[r] = vm[r] ? __builtin_amdgcn_exp2f(zb[r] + run) : 0.f; run += lk[r]; }
        R = (R + Thi) + Tlo;
        const bf16x8 pa0 = pack8(w[0], w[1], w[2], w[3], w[4], w[5], w[6], w[7]), pa1 = pack8(w[8], w[9], w[10], w[11], w[12], w[13], w[14], w[15]);
#pragma unroll
        for (int c = 0; c < 4; ++c) {
            o[c] = __builtin_amdgcn_mfma_f32_32x32x16_bf16(vf[c * 2 + 0], pa0, o[c], 0, 0, 0);
            o[c] = __builtin_amdgcn_mfma_f32_32x32x16_bf16(vf[c * 2 + 1], pa1, o[c], 0, 0, 0);
        }
        if (__all((R < -160.f) || !qvalid)) break;
    }
    float ss = 0.f;
#pragma unroll
    for (int c = 0; c < 4; ++c)
#pragma unroll
        for (int r = 0; r < 16; ++r) ss += o[c][r] * o[c][r];
    ss += __shfl_xor(ss, 32);
    const float rinv = 1.0f / sqrtf(ss * (1.f / 128.f) + EPS);
    if (qvalid && (b == 0 || pq >= NMETA)) {
        bf16* orow = F.XN + pos_row(b, pq) * D + 2048 + hd * 128 + 4 * hh;
        const float* wv = F.sbn_w + hd * 128 + 4 * hh;
#pragma unroll
        for (int c = 0; c < 4; ++c)
#pragma unroll
            for (int q4 = 0; q4 < 4; ++q4) {
                const f32x4 wn = *(const GAS f32x4*)(wv + 32 * c + 8 * q4);
                v2u ov; ov.x = cvtpk(o[c][4 * q4] * rinv * wn.x, o[c][4 * q4 + 1] * rinv * wn.y); ov.y = cvtpk(o[c][4 * q4 + 2] * rinv * wn.z, o[c][4 * q4 + 3] * rinv * wn.w);
                *(GAS v2u*)(orow + 32 * c + 8 * q4) = ov;
            }
    }
}

__device__ __forceinline__ void p2_mixers(Frame& F) {
    if (F.wave < 2) {
        for (int unit = F.vcu * 2 + F.wave; unit < NB * RET_H * 16; unit += F.G * 2) ret_unit(F, unit >> 7, (unit >> 4) & 7, unit & 15);
    } else {
        constexpr int NSLAB = (SEQ + NMETA + 31) / 32;
        for (int it = F.vcu * 6 + (F.wave - 2); it < NB * SB_H * NSLAB; it += F.G * 6) { const int bh = it / NSLAB, sl = it % NSLAB; sb_unit(F, bh >> 4, bh & 15, sl); }
    }
}

__device__ __forceinline__ void p3_retnorm(Frame& F) {
    const int gw = F.vcu * NWAVES + F.wave, NGW = F.G * NWAVES, lane = F.lane;
    for (int item = gw; item < RET_H * MROWS; item += NGW) {
        const int h = item & 7, rr = item >> 3;
        GAS v2u* yp = (GAS v2u*)(F.XN + (size_t)rr * D + h * 256 + 4 * lane);
        const v2u yv = *yp; const float o0 = bflo(yv.x), o1 = bfhi(yv.x), o2 = bflo(yv.y), o3 = bfhi(yv.y);
        const float ss = wave_sum(o0 * o0 + o1 * o1 + o2 * o2 + o3 * o3);
        const float r = 1.0f / sqrtf(ss * (1.f / 256.f) + EPS);
        const f32x4 gw4 = *(const GAS f32x4*)(F.gn_w + h * 256 + 4 * lane);
        const v2u gv = *(const GAS v2u*)(F.PROJ + (size_t)rr * IN_COLS + C_RG + h * 256 + 4 * lane);
        const float g0 = bflo(gv.x), g1 = bfhi(gv.x), g2 = bflo(gv.y), g3 = bfhi(gv.y);
        const float y0 = g0 / (1.f + __expf(-g0)) * (o0 * r * gw4.x), y1 = g1 / (1.f + __expf(-g1)) * (o1 * r * gw4.y);
        const float y2 = g2 / (1.f + __expf(-g2)) * (o2 * r * gw4.z), y3 = g3 / (1.f + __expf(-g3)) * (o3 * r * gw4.w);
        v2u ov; ov.x = pk2(y0, y1); ov.y = pk2(y2, y3); *yp = ov;
    }
}

__device__ __forceinline__ void p4_norms(Frame& F) {
    const int gw = F.vcu * NWAVES + F.wave, NGW = F.G * NWAVES;
    for (int m = gw; m < MROWS; m += NGW) {
        GAS f32x4* ar = (GAS f32x4*)(m < MSEQ ? F.out + (size_t)m * D : F.META + (size_t)(m - MSEQ) * D) + F.lane;
        const GAS f32x4* hr = (const GAS f32x4*)h_row(F, m) + F.lane;
        const GAS f32x4* wp = (const GAS f32x4*)F.w_post + F.lane; const GAS f32x4* wq = (const GAS f32x4*)F.w_pre2 + F.lane;
        f32x4 v[16]; float s = 0.f;
#pragma unroll
        for (int j = 0; j < 16; ++j) { v[j] = ar[64 * j]; s += (v[j].x * v[j].x + v[j].y * v[j].y) + (v[j].z * v[j].z + v[j].w * v[j].w); }
        const float r = 1.0f / sqrtf(wave_sum(s) * (1.f / D) + EPS); float s2 = 0.f;
#pragma unroll
        for (int j = 0; j < 16; ++j) { const f32x4 w = wp[64 * j], hv = hr[64 * j]; v[j] = hv + v[j] * r * w; ar[64 * j] = v[j]; s2 += (v[j].x * v[j].x + v[j].y * v[j].y) + (v[j].z * v[j].z + v[j].w * v[j].w); }
        const float r2 = 1.0f / sqrtf(wave_sum(s2) * (1.f / D) + EPS);
        GAS v2u* o8 = (GAS v2u*)(F.XN + (size_t)m * D) + F.lane;
#pragma unroll
        for (int j = 0; j < 16; ++j) { const f32x4 w = wq[64 * j]; v2u o; o.x = pk2(v[j].x * r2 * w.x, v[j].y * r2 * w.y); o.y = pk2(v[j].z * r2 * w.z, v[j].w * r2 * w.w); o8[64 * j] = o; }
    }
}

__device__ __forceinline__ void p6_fixup(Frame& F) {
    const int gt = F.vcu * (NWAVES * 64) + F.tid, NGT = F.G * NWAVES * 64;
    constexpr int QC = DFF / 4;
    for (int i = gt; i < 256 * QC; i += NGT) {
        const int sg = i / QC, jq = i % QC, j = 4 * jq;
        const int prev = (sg & 63) == 0 ? 256 : sg - 1;
        const f32x4 h0 = *(const GAS f32x4*)(F.HALO + ((size_t)prev * 2 + 0) * DFF + j), h1 = *(const GAS f32x4*)(F.HALO + ((size_t)prev * 2 + 1) * DFF + j);
        const f32x4 g0 = *(const GAS f32x4*)(F.FIRSTG + ((size_t)sg * 2 + 0) * DFF + j), g1 = *(const GAS f32x4*)(F.FIRSTG + ((size_t)sg * 2 + 1) * DFF + j);
        const f32x4 u0 = *(const GAS f32x4*)(F.FIRSTU + ((size_t)sg * 2 + 0) * DFF + j), u1 = *(const GAS f32x4*)(F.FIRSTU + ((size_t)sg * 2 + 1) * DFF + j);
        const f32x4 w0 = *(const GAS f32x4*)(F.conv_w + j), w1 = *(const GAS f32x4*)(F.conv_w + DFF + j), w2 = *(const GAS f32x4*)(F.conv_w + 2 * DFF + j), bb = *(const GAS f32x4*)(F.conv_b + j);
        float a0[4], a1[4];
#pragma unroll
        for (int e = 0; e < 4; ++e) {
            const float c0 = bb[e] + w0[e] * h0[e] + w1[e] * h1[e] + w2[e] * g0[e];
            const float c1 = bb[e] + w0[e] * h1[e] + w1[e] * g0[e] + w2[e] * g1[e];
            a0[e] = c0 / (1.f + __expf(-c0)) * u0[e]; a1[e] = c1 / (1.f + __expf(-c1)) * u1[e];
        }
        v2u o; o.x = pk2(a0[0], a0[1]); o.y = pk2(a0[2], a0[3]); *(GAS v2u*)(F.ACT + (size_t)(sg * 64) * DFF + j) = o;
        o.x = pk2(a1[0], a1[1]); o.y = pk2(a1[2], a1[3]); *(GAS v2u*)(F.ACT + (size_t)(sg * 64 + 1) * DFF + j) = o;
    }
}

__device__ __forceinline__ void p8_final(Frame& F) {
    const int gw = F.vcu * NWAVES + F.wave, NGW = F.G * NWAVES;
    for (int m = gw; m < MSEQ; m += NGW) {
        GAS f32x4* orow = (GAS f32x4*)(F.out + (size_t)m * D) + F.lane; const GAS f32x4* fr = (const GAS f32x4*)(F.Fb + (size_t)m * D) + F.lane;
        const GAS f32x4* wp = (const GAS f32x4*)F.w_post2 + F.lane;
        f32x4 v[16]; float s = 0.f;
#pragma unroll
        for (int j = 0; j < 16; ++j) { v[j] = fr[64 * j]; s += (v[j].x * v[j].x + v[j].y * v[j].y) + (v[j].z * v[j].z + v[j].w * v[j].w); }
        const float r = 1.0f / sqrtf(wave_sum(s) * (1.f / D) + EPS);
#pragma unroll
        for (int j = 0; j < 16; ++j) { const f32x4 w = wp[64 * j]; orow[64 * j] = orow[64 * j] + v[j] * r * w; }
    }
}

struct Args { const float* in[14]; float* out; unsigned char* ws; int ph_lo, ph_hi; };
__global__ void __launch_bounds__(NWAVES * 64, 2) hymba_fwd(Args args) {
    extern __shared__ __attribute__((aligned(16))) unsigned char lds[];
    Frame F;
    F.lds = (LAS unsigned char*)lds;
    F.MISC = (volatile LAS unsigned*)(F.lds + MISC_OFF);
    F.tid = threadIdx.x; F.lane = F.tid & 63; F.wave = __builtin_amdgcn_readfirstlane(F.tid >> 6);
    F.G = gridDim.x; { const int bx = blockIdx.x; F.vcu = (F.G % 8 == 0) ? (bx % 8) * (F.G / 8) + bx / 8 : bx; }
    unsigned char* ws = args.ws;
    F.ctl = (gu32*)(ws + WS_CTL);
    F.x = args.in[0]; F.meta = args.in[1]; F.w_pre = args.in[2]; F.w_in = args.in[3]; F.gn_w = args.in[4]; F.sbn_w = args.in[5]; F.w_out = args.in[6]; F.w_post = args.in[7];
    F.w_pre2 = args.in[8]; F.w_up = args.in[9]; F.conv_w = args.in[10]; F.conv_b = args.in[11]; F.w_down = args.in[12]; F.w_post2 = args.in[13]; F.out = args.out;
    F.WIN = (bf16*)(ws + WS_WIN); F.WOUT = (bf16*)(ws + WS_WOUT); F.WUP = (bf16*)(ws + WS_WUP); F.WDOWN = (bf16*)(ws + WS_WDOWN); F.XN = (bf16*)(ws + WS_XN);
    F.PROJ = (bf16*)(ws + WS_PROJ); F.ACT = (bf16*)(ws + WS_ACT); F.META = (float*)(ws + WS_META); F.HALO = (float*)(ws + WS_HALO); F.FIRSTG = (float*)(ws + WS_FIRSTG);
    F.FIRSTU = (float*)(ws + WS_FIRSTU); F.Fb = (float*)(ws + WS_F); F.KST = (bf16*)(ws + WS_KST); F.VT = (bf16*)(ws + WS_VT); F.SVT = (bf16*)(ws + WS_SVT);
    for (int u = F.tid; u < (LDS_BYTES - LDSCTL_OFF) / 4; u += NWAVES * 64) ((LAS unsigned*)(F.lds + LDSCTL_OFF))[u] = 0u;
    __syncthreads();
    XcdBarrier bar; bar.bar = (unsigned*)(F.ctl + CW_BAR); bar.x = 0; bar.st = nullptr;
    if (N_LAUNCHES == 1) bar = xcd_barrier_post((unsigned*)(F.ctl + CW_BAR), F.MISC + 8);
#define GRID_BAR() do { if (N_LAUNCHES == 1) xcd_barrier(bar); } while (0)
    const int lo = args.ph_lo, hi = args.ph_hi;
#define IN(k) (lo <= (k) && (k) < hi)
#define BOTH(k) (IN(k) && IN((k) + 1))

    if (IN(0)) { p0_prologue(F); if (BOTH(0)) GRID_BAR(); }
    if (IN(1)) {
        pg8::Gemm g{F.XN, F.WIN, MPAD, IN_COLS, D}; pg8::StaticOrder S; S.init(MPAD, IN_COLS, F.G, (int)blockIdx.x);
        pg8::EpiProj E{F.PROJ, IN_COLS, ROPE_REV, F.KST, F.VT, F.SVT};
        pg8::gemm_phase<pg8::EpiProj, pg8::StaticOrder, PG8_ALIGN, PG8_SP2>(F.lds + RING_OFF, g, S, E);
        if (BOTH(1)) GRID_BAR();
    }
    if (IN(2)) { p2_mixers(F); if (BOTH(2)) GRID_BAR(); }
    if (IN(3)) { p3_retnorm(F); if (BOTH(3)) GRID_BAR(); }
    if (IN(4)) {
        pg8::Gemm g{F.XN, F.WOUT, MPAD, D, D}; pg8::StaticOrder S; S.init(MPAD, D, F.G, (int)blockIdx.x);
        pg8::EpiF32Split E{F.out, F.META, MSEQ, D};
        pg8::gemm_phase<pg8::EpiF32Split, pg8::StaticOrder, PG8_ALIGN, PG8_SP2>(F.lds + RING_OFF, g, S, E);
        if (BOTH(4)) GRID_BAR();
    }
    if (IN(5)) { p4_norms(F); if (BOTH(5)) GRID_BAR(); }
    if (IN(6)) {
        pg8::Gemm g{F.XN, F.WUP, MPAD, NUP, D}; pg8::StaticOrder S; S.init(MPAD, NUP, F.G, (int)blockIdx.x);
        pg8::EpiConv E{F.ACT, F.HALO, F.FIRSTG, F.FIRSTU, F.conv_w, F.conv_b, DFF};
        pg8::gemm_phase<pg8::EpiConv, pg8::StaticOrder, PG8_ALIGN, PG8_SP2>(F.lds + RING_OFF, g, S, E);
        if (BOTH(6)) GRID_BAR();
    }
    if (IN(7)) { p6_fixup(F); if (BOTH(7)) GRID_BAR(); }
    if (IN(8)) {
        pg8::Gemm g{F.ACT, F.WDOWN, MSEQ, D, DFF}; pg8::StaticOrder S; S.init(MSEQ, D, F.G, (int)blockIdx.x);
        pg8::EpiF32Split E{F.Fb, F.Fb, MSEQ, D};
        pg8::gemm_phase<pg8::EpiF32Split, pg8::StaticOrder, PG8_ALIGN, PG8_SP2>(F.lds + RING_OFF, g, S, E);
        if (BOTH(8)) GRID_BAR();
    }
    if (IN(9)) { p8_final(F); }
#undef IN
#undef BOTH
}

extern "C" void kernel_launch(void* const* d_in, const int* in_sizes, int n_in, void* d_out, int out_size, void* d_ws, size_t ws_size, hipStream_t stream) {
    static int grid = 0;
    if (grid == 0) {
        if (n_in != 14 || out_size != MSEQ * D || ws_size < WS_END) { fprintf(stderr, "kernel_launch: unexpected shapes (n_in %d, out %d, ws %zu < %zu)\n", n_in, out_size, ws_size, (size_t)WS_END); grid = -1; return; }
        int dev = 0, cus = 0, per_cu = 0;
        if (hipGetDevice(&dev) != hipSuccess || hipDeviceGetAttribute(&cus, hipDeviceAttributeMultiprocessorCount, dev) != hipSuccess) { grid = -1; return; }
        if (hipFuncSetAttribute((const void*)hymba_fwd, hipFuncAttributeMaxDynamicSharedMemorySize, LDS_BYTES) != hipSuccess) { fprintf(stderr, "kernel_launch: hipFuncSetAttribute failed\n"); grid = -1; return; }
        if (hipOccupancyMaxActiveBlocksPerMultiprocessor(&per_cu, (const void*)hymba_fwd, NWAVES * 64, LDS_BYTES) != hipSuccess || per_cu < 1) fprintf(stderr, "kernel_launch: occupancy query reports %d\n", per_cu);
        (void)hipGetLastError();
        grid = cus;
    }
    if (grid < 0) return;
    if (hipMemsetAsync((char*)d_ws + WS_CTL, 0, CTL_ZERO_BYTES, stream) != hipSuccess) return;
    Args a{};
    for (int i = 0; i < 14; ++i) a.in[i] = (const float*)d_in[i];
    a.out = (float*)d_out; a.ws = (unsigned char*)d_ws;
    if (N_LAUNCHES == 1) { a.ph_lo = 0; a.ph_hi = N_PHASES; hipLaunchKernelGGL(hymba_fwd, dim3(grid), dim3(NWAVES * 64), LDS_BYTES, stream, a); }
    else for (int p = 0; p < N_PHASES; ++p) { a.ph_lo = p; a.ph_hi = p + 1; hipLaunchKernelGGL(hymba_fwd, dim3(grid), dim3(NWAVES * 64), LDS_BYTES, stream, a); }
    const hipError_t le = hipPeekAtLastError();
    if (le != hipSuccess) fprintf(stderr, "kernel_launch: launch failed: %s\n", hipGetErrorName(le));
}
```

```cpp
#include <hip/hip_runtime.h>
#include <cstdio>
#include <cstdint>
namespace pg8 {
#define PG8_LAS __attribute__((address_space(3)))
typedef unsigned short bf16_t;
typedef short bf16x8 __attribute__((ext_vector_type(8)));
typedef float f32x4 __attribute__((ext_vector_type(4)));
typedef unsigned u32x4 __attribute__((ext_vector_type(4)));
constexpr int BM = 256, BK = 64, HALF = 128, HTB = HALF * BK * 2  , STAGE_BYTES = 8 * HTB, NXCD = 8, WGM = 8;

__host__ __device__ __forceinline__ int lds_byte(int r, int c) { const int st = (r >> 4) * 2 + (c >> 5), rr = r & 15, cc = c & 31, ob = rr * 64 + cc * 2; return st * 1024 + (ob ^ (((ob >> 9) & 1) << 5)); }
__host__ __device__ __forceinline__ void stage_rc(int b, int& R, int& C) { const int st = b / 1024, sb = b % 1024, swz = sb ^ (((sb >> 9) & 1) << 5); R = (st >> 1) * 16 + swz / 64; C = (st & 1) * 32 + (swz % 64) / 2; }
__host__ __device__ __forceinline__ int perm32(int rho) { const int n = rho >> 4, i = rho & 15; return 8 * (i >> 2) + 4 * n + (i & 3); }

struct Unit { int pm, pn; };
struct Gemm { const bf16_t* A; const bf16_t* Bt; int M, N, K; };

struct StaticOrder {
    int nM, nN, nwg, G, c;
    __host__ __device__ void init(int M, int N, int G_, int c_) { nM = M / BM; nN = N / BM; nwg = nM * nN; G = G_; c = c_; }
    __host__ __device__ bool next(int i, Unit& u) const {
        const long L = (long)i * G + c; if (L >= nwg) return false;
        int wgid = (int)L; { const int q = nwg / NXCD, r = nwg % NXCD, xcd = wgid % NXCD, off = wgid / NXCD; wgid = (xcd < r ? xcd * (q + 1) : r * (q + 1) + (xcd - r) * q) + off; }
        const int nig = WGM * nN, gid = wgid / nig, fm = gid * WGM, gsz = (nM - fm) < WGM ? (nM - fm) : WGM;
        u.pm = fm + ((wgid % nig) % gsz); u.pn = (wgid % nig) / gsz; return true;
    }
    __device__ __forceinline__ void a_ready(const Unit&) const {}
    __device__ __forceinline__ void done(const Unit&) const {}
};

typedef float f32x2_t __attribute__((ext_vector_type(2))); typedef __bf16 bf16x2_t __attribute__((ext_vector_type(2)));
__device__ __forceinline__ unsigned cvt_pk_bf16(float lo, float hi) { f32x2_t v = {lo, hi}; bf16x2_t b = __builtin_convertvector(v, bf16x2_t); return __builtin_bit_cast(unsigned, b); }

constexpr int PPR = 4128, PPS = 4128, RPAD = 16, RCH = 32;
struct EpiProj {
    static constexpr bool PERM = true, AFTER_DRAIN = false;
    bf16_t* O; int ldc; const float* rope_rev; bf16_t* KST; bf16_t* VT; bf16_t* SVT; PG8_LAS unsigned char* tsl;
    __device__ __forceinline__ void tstore_lds(PG8_LAS unsigned char* scr, const u32x4 w, bf16_t* base, int H, int Dh, int PP, int hd, int d0, int row_base, int padoff, int lane) const {
        *(PG8_LAS u32x4*)(scr + (lane & 15) * 80 + (lane >> 4) * 16) = w;
        asm volatile("s_waitcnt lgkmcnt(0)" ::: "memory");
        const int c = lane & 31, rh = lane >> 5;
        const PG8_LAS unsigned short* rp = (const PG8_LAS unsigned short*)(scr + (8 * rh) * 80 + c * 2);
        u32x4 t; t.x = (unsigned)rp[0] | ((unsigned)rp[40] << 16); t.y = (unsigned)rp[80] | ((unsigned)rp[120] << 16); t.z = (unsigned)rp[160] | ((unsigned)rp[200] << 16); t.w = (unsigned)rp[240] | ((unsigned)rp[280] << 16);
        asm volatile("s_waitcnt lgkmcnt(0)" ::: "memory");
        if (row_base < 16384) { *(u32x4*)(base + ((size_t)((row_base >> 12) * H + hd) * Dh + d0 + c) * PP + (row_base & 4095) + 16 + padoff + 8 * rh) = t; }
        else if (row_base == 16384) {
#pragma unroll
            for (int b = 0; b < 4; ++b) *(u32x4*)(base + ((size_t)(b * H + hd) * Dh + d0 + c) * PP + padoff + 8 * rh) = t; }
    }
    __device__ __forceinline__ void operator()(const f32x4 (&acc)[2][2][4][2], const Unit& u, int wr, int wc, int fr, int fq) const {
        const int row0 = u.pm * BM + wr * 64 + fr, cl = wc * 32 + 8 * fq, col0 = u.pn * BM + cl, pn = u.pn, lane = fq * 16 + fr;
        PG8_LAS unsigned char* scr = tsl + (wr * 4 + wc) * 1536;
        if (pn < 16) {
            const f32x4 iv0 = *(const f32x4*)(rope_rev + cl), iv1 = *(const f32x4*)(rope_rev + cl + 4);
            const int h = pn & 7; const float lgh = __builtin_log2f(1.0f - __builtin_exp2f(-5.0f - (float)h));
#pragma unroll
            for (int ai = 0; ai < 2; ++ai)
#pragma unroll
                for (int m = 0; m < 4; ++m) {
                    const int row = row0 + ai * HALF + m * 16;
                    const int p = row < 16384 ? (row & 4095) + 16 : row - 16384;
                    const float pos = (float)p, ml = (float)((p + RPAD) & (RCH - 1));
                    const float sc = pn < 8 ? 0.0625f * __builtin_exp2f(ml * lgh) : __builtin_exp2f(-ml * lgh);
                    bf16_t* rowp = O + (size_t)row * ldc + col0;
                    float o0[8], o1[8];
#pragma unroll
                    for (int n = 0; n < 2; ++n)
#pragma unroll
                        for (int j = 0; j < 4; ++j) {
                            float t = pos * (n ? iv1[j] : iv0[j]); t = t - floorf(t);
                            const float sn = __builtin_amdgcn_sinf(t), cs = __builtin_amdgcn_cosf(t);
                            const float x1 = acc[ai][0][m][n][j], x2 = acc[ai][1][m][n][j];
                            o0[n * 4 + j] = (x1 * cs - x2 * sn) * sc; o1[n * 4 + j] = (x1 * sn + x2 * cs) * sc;
                        }
                    u32x4 w0, w1; w0.x = cvt_pk_bf16(o0[0], o0[1]); w0.y = cvt_pk_bf16(o0[2], o0[3]); w0.z = cvt_pk_bf16(o0[4], o0[5]); w0.w = cvt_pk_bf16(o0[6], o0[7]);
                    *(u32x4*)(rowp) = w0;
                    w1.x = cvt_pk_bf16(o1[0], o1[1]); w1.y = cvt_pk_bf16(o1[2], o1[3]); w1.z = cvt_pk_bf16(o1[4], o1[5]); w1.w = cvt_pk_bf16(o1[6], o1[7]);
                    *(u32x4*)(rowp + HALF) = w1;
                    if (pn >= 8) { const int rb = u.pm * BM + ai * HALF + wr * 64 + m * 16;
                        tstore_lds(scr, w0, KST, 8, 256, PPR, h, wc * 32, rb, RPAD, lane); tstore_lds(scr, w1, KST, 8, 256, PPR, h, HALF + wc * 32, rb, RPAD, lane); }
                }
        } else if (pn < 24 || pn >= 48) {
            const bool isr = pn < 24;
#pragma unroll
            for (int ai = 0; ai < 2; ++ai)
#pragma unroll
                for (int m = 0; m < 4; ++m) {
                    const int rb = u.pm * BM + ai * HALF + wr * 64 + m * 16;
#pragma unroll
                    for (int bj = 0; bj < 2; ++bj) {
                        const f32x4 v0 = acc[ai][bj][m][0], v1 = acc[ai][bj][m][1];
                        u32x4 w; w.x = cvt_pk_bf16(v0[0], v0[1]); w.y = cvt_pk_bf16(v0[2], v0[3]); w.z = cvt_pk_bf16(v1[0], v1[1]); w.w = cvt_pk_bf16(v1[2], v1[3]);
                        if (isr) tstore_lds(scr, w, VT, 8, 256, PPR, pn - 16, bj * HALF + wc * 32, rb, RPAD, lane);
                        else tstore_lds(scr, w, SVT, 16, 128, PPS, 2 * (pn - 48) + bj, wc * 32, rb, 0, lane);
                    }
                }
        } else {
            const float sc = (pn >= 32 && pn < 40) ? 0.12751743082459868f : 1.0f;
#pragma unroll
            for (int ai = 0; ai < 2; ++ai)
#pragma unroll
                for (int m = 0; m < 4; ++m) { bf16_t* rowp = O + (size_t)(row0 + ai * HALF + m * 16) * ldc + col0;
#pragma unroll
                    for (int bj = 0; bj < 2; ++bj) { const f32x4 v0 = acc[ai][bj][m][0] * sc, v1 = acc[ai][bj][m][1] * sc;
                        u32x4 w; w.x = cvt_pk_bf16(v0[0], v0[1]); w.y = cvt_pk_bf16(v0[2], v0[3]); w.z = cvt_pk_bf16(v1[0], v1[1]); w.w = cvt_pk_bf16(v1[2], v1[3]);
                        *(u32x4*)(rowp + bj * HALF) = w; } }
        }
    }
};

struct EpiBf16Plain {
    static constexpr bool PERM = true, AFTER_DRAIN = false;
    bf16_t* O; int ldc;
    __device__ __forceinline__ void operator()(const f32x4 (&acc)[2][2][4][2], const Unit& u, int wr, int wc, int fr, int fq) const {
        const int row0 = u.pm * BM + wr * 64 + fr, col0 = u.pn * BM + wc * 32 + 8 * fq;
#pragma unroll
        for (int ai = 0; ai < 2; ++ai)
#pragma unroll
            for (int m = 0; m < 4; ++m) { bf16_t* rowp = O + (size_t)(row0 + ai * HALF + m * 16) * ldc + col0;
#pragma unroll
                for (int bj = 0; bj < 2; ++bj) { const f32x4 v0 = acc[ai][bj][m][0], v1 = acc[ai][bj][m][1];
                    u32x4 w; w.x = cvt_pk_bf16(v0[0], v0[1]); w.y = cvt_pk_bf16(v0[2], v0[3]); w.z = cvt_pk_bf16(v1[0], v1[1]); w.w = cvt_pk_bf16(v1[2], v1[3]);
                    *(u32x4*)(rowp + bj * HALF) = w; } }
    }
};

struct EpiF32Split {
    static constexpr bool PERM = false, AFTER_DRAIN = false;
    float* C0; float* C1; int rows0; int ldc;
    __device__ __forceinline__ void operator()(const f32x4 (&acc)[2][2][4][2], const Unit& u, int wr, int wc, int fr, int fq) const {
        const int row0 = u.pm * BM + wr * 64 + fr, col0 = u.pn * BM + wc * 32 + 4 * fq;
        float* base = row0 < rows0 ? C0 + (size_t)row0 * ldc : C1 + (size_t)(row0 - rows0) * ldc;
#pragma unroll
        for (int ai = 0; ai < 2; ++ai)
#pragma unroll
            for (int m = 0; m < 4; ++m) { float* rowp = base + (size_t)(ai * HALF + m * 16) * ldc + col0;
#pragma unroll
                for (int bj = 0; bj < 2; ++bj)
#pragma unroll
                    for (int n = 0; n < 2; ++n) *(f32x4*)(rowp + bj * HALF + n * 16) = acc[ai][bj][m][n]; }
    }
};

struct EpiConv {
    static constexpr bool PERM = true, AFTER_DRAIN = false;
    bf16_t* ACT; float* HALO; float* FIRSTG; float* FIRSTU; const float* cw; const float* cb; int dff;
    __device__ __forceinline__ void operator()(const f32x4 (&acc)[2][2][4][2], const Unit& u, int wr, int wc, int fr, int fq) const {
        const int lane = fq * 16 + fr, j0 = u.pn * HALF + wc * 32 + 8 * fq;
        if (u.pm == 64) {
            if (wr == 0 && fr >= 14) { float* hp = HALO + ((size_t)256 * 2 + (fr - 14)) * dff + j0; *(f32x4*)hp = acc[0][0][0][0]; *(f32x4*)(hp + 4) = acc[0][0][0][1]; }
            return;
        }
        f32x4 w0[2], w1[2], w2[2], bb[2];
#pragma unroll
        for (int n = 0; n < 2; ++n) { w0[n] = *(const f32x4*)(cw + j0 + 4 * n); w1[n] = *(const f32x4*)(cw + dff + j0 + 4 * n); w2[n] = *(const f32x4*)(cw + 2 * dff + j0 + 4 * n); bb[n] = *(const f32x4*)(cb + j0 + 4 * n); }
#pragma unroll
        for (int ai = 0; ai < 2; ++ai) {
            const int sg = u.pm * 4 + ai * 2 + wr;
#pragma unroll
            for (int m = 0; m < 4; ++m) {
                const int row = u.pm * BM + ai * HALF + wr * 64 + m * 16 + fr;
                float o[8];
#pragma unroll
                for (int n = 0; n < 2; ++n)
#pragma unroll
                    for (int j = 0; j < 4; ++j) {
                        const float g = acc[ai][0][m][n][j], gp = m > 0 ? acc[ai][0][m > 0 ? m - 1 : 0][n][j] : 0.f;
                        const float snd1 = fr == 15 ? gp : g, snd2 = fr >= 14 ? gp : g;
                        const float x1 = __builtin_bit_cast(float, __builtin_amdgcn_update_dpp(0, __builtin_bit_cast(int, snd1), 0x121, 0xf, 0xf, false));
                        const float x2 = __builtin_bit_cast(float, __builtin_amdgcn_update_dpp(0, __builtin_bit_cast(int, snd2), 0x122, 0xf, 0xf, false));
                        const float cv = bb[n][j] + w0[n][j] * x2 + w1[n][j] * x1 + w2[n][j] * g;
                        const float sl = cv * __builtin_amdgcn_rcpf(1.0f + __builtin_amdgcn_exp2f(-1.4426950408889634f * cv));
                        o[n * 4 + j] = sl * acc[ai][1][m][n][j];
                    }
                if (m == 0 && fr < 2) {
                    float* gpz = FIRSTG + ((size_t)sg * 2 + fr) * dff + j0; float* upz = FIRSTU + ((size_t)sg * 2 + fr) * dff + j0;
                    *(f32x4*)gpz = acc[ai][0][0][0]; *(f32x4*)(gpz + 4) = acc[ai][0][0][1]; *(f32x4*)upz = acc[ai][1][0][0]; *(f32x4*)(upz + 4) = acc[ai][1][0][1];
                } else {
                    u32x4 w; w.x = cvt_pk_bf16(o[0], o[1]); w.y = cvt_pk_bf16(o[2], o[3]); w.z = cvt_pk_bf16(o[4], o[5]); w.w = cvt_pk_bf16(o[6], o[7]);
                    *(u32x4*)(ACT + (size_t)row * dff + j0) = w;
                }
                if (m == 3 && fr >= 14) { float* hp = HALO + ((size_t)sg * 2 + (fr - 14)) * dff + j0; *(f32x4*)hp = acc[ai][0][3][0]; *(f32x4*)(hp + 4) = acc[ai][0][3][1]; }
            }
        }
    }
};

template <class Epi, class Sched, bool ALIGN_EPI = false, bool SP2 = false>
__device__ __forceinline__ void gemm_phase(PG8_LAS unsigned char* lds, const Gemm g, const Sched& S, const Epi& E) {
    const int tid = threadIdx.x, wid = __builtin_amdgcn_readfirstlane(tid >> 6), lane = tid & 63, wr = wid >> 2, wc = wid & 3, fr = lane & 15, fq = lane >> 4;
    const int K = g.K, nt = K / BK;
    unsigned voffA[2], voffB[2];
#pragma unroll
    for (int i = 0; i < 2; ++i) { int R, C; stage_rc(tid * 16 + i * 8192, R, C); const int Rb = Epi::PERM ? ((R & ~31) + perm32(R & 31)) : R;
        voffA[i] = (unsigned)(R * K + C) * 2u; voffB[i] = (unsigned)(Rb * K + C) * 2u; }
    const size_t kstep = (size_t)(BK * 2);
    const size_t hstep = (size_t)HALF * K * 2;
    const size_t tstep = 2 * hstep;
    const unsigned ldsw = (unsigned)wid * 1024u;
    const int aoff = lds_byte(wr * 64 + fr, fq * 8), boff = lds_byte(wc * 32 + fr, fq * 8);
#define PG8_SA(b, h) (((b) * 2 + (h)) * HTB)
#define PG8_SB(b, h) ((4 + (b) * 2 + (h)) * HTB)
#define PG8_STAGE(bufoff, gbase, voff) do { _Pragma("unroll") for (int _i = 0; _i < 2; ++_i) \
        __builtin_amdgcn_global_load_lds((const unsigned*)((const char*)(gbase) + (voff)[_i]), (PG8_LAS unsigned*)(lds + (bufoff) + ldsw + _i * 8192), 16, 0, 0); } while (0)
#define PG8_LDA(dst, b, h) do { _Pragma("unroll") for (int m = 0; m < 4; ++m) _Pragma("unroll") for (int k = 0; k < 2; ++k) dst[m][k] = *(const PG8_LAS bf16x8*)(lds + PG8_SA(b, h) + aoff + m * 2048 + k * 1024); } while (0)
#define PG8_LDB(dst, b, h) do { _Pragma("unroll") for (int n = 0; n < 2; ++n) _Pragma("unroll") for (int k = 0; k < 2; ++k) dst[n][k] = *(const PG8_LAS bf16x8*)(lds + PG8_SB(b, h) + boff + n * 2048 + k * 1024); } while (0)
#define PG8_MMA(ai, bj, At, Bt) do { __builtin_amdgcn_s_setprio(1); _Pragma("unroll") for (int m = 0; m < 4; ++m) _Pragma("unroll") for (int n = 0; n < 2; ++n) _Pragma("unroll") for (int k = 0; k < 2; ++k) \
        acc[ai][bj][m][n] = __builtin_amdgcn_mfma_f32_16x16x32_bf16(Bt[n][k], At[m][k], acc[ai][bj][m][n], 0, 0, 0); __builtin_amdgcn_s_setprio(0); } while (0)
#define PG8_WAIT_V(n) asm volatile("s_waitcnt vmcnt(" #n ")" ::: "memory")
#define PG8_WAIT_L(n) asm volatile("s_waitcnt lgkmcnt(" #n ")" ::: "memory")
#define PG8_BAR __builtin_amdgcn_s_barrier()
#define PG8_SCHED __builtin_amdgcn_sched_barrier(0)
    Unit cur, nxt; int ui = 0;
    if (!S.next(0, cur)) return;
    f32x4 acc[2][2][4][2];
#pragma unroll
    for (int a = 0; a < 2; ++a)
#pragma unroll
        for (int b = 0; b < 2; ++b)
#pragma unroll
            for (int m = 0; m < 4; ++m)
#pragma unroll
                for (int n = 0; n < 2; ++n) acc[a][b][m][n] = (f32x4){0.f, 0.f, 0.f, 0.f};
    bf16x8 At[4][2], B0[2][2], B1[2][2];
    const char* cA = (const char*)g.A + (size_t)cur.pm * tstep; const char* cB = (const char*)g.Bt + (size_t)cur.pn * tstep;
    S.a_ready(cur);
    if constexpr (SP2) {
        PG8_STAGE(PG8_SB(0, 0), cB, voffB); PG8_STAGE(PG8_SB(0, 1), cB + hstep, voffB); PG8_STAGE(PG8_SA(0, 0), cA, voffA); PG8_STAGE(PG8_SA(0, 1), cA + hstep, voffA);
        if (wr == 1) PG8_BAR;
        PG8_WAIT_V(2); PG8_BAR;
        PG8_STAGE(PG8_SB(1, 0), cB + kstep, voffB); PG8_STAGE(PG8_SA(1, 0), cA + kstep, voffA); PG8_STAGE(PG8_SB(1, 1), cB + hstep + kstep, voffB);
        PG8_WAIT_V(6); PG8_BAR;
    } else {
        PG8_STAGE(PG8_SB(0, 0), cB, voffB); PG8_STAGE(PG8_SA(0, 0), cA, voffA); PG8_STAGE(PG8_SB(0, 1), cB + hstep, voffB); PG8_STAGE(PG8_SA(0, 1), cA + hstep, voffA);
        if (wr == 1) PG8_BAR;
        PG8_WAIT_V(4); PG8_BAR;
        PG8_STAGE(PG8_SB(1, 0), cB + kstep, voffB); PG8_STAGE(PG8_SA(1, 0), cA + kstep, voffA); PG8_STAGE(PG8_SB(1, 1), cB + hstep + kstep, voffB);
        PG8_WAIT_V(6); PG8_BAR;
    }
    for (;;) {
        const bool has_next = S.next(ui + 1, nxt);
        const char* nA = has_next ? (const char*)g.A + (size_t)nxt.pm * tstep : cA; const char* nB = has_next ? (const char*)g.Bt + (size_t)nxt.pn * tstep : cB;
        for (int t = 0; t < nt; t += 2) {
            const bool last = (t == nt - 2);
            const char* a1 = cA + (size_t)(t + 1) * kstep;
            const char* a2 = last ? nA : cA + (size_t)(t + 2) * kstep; const char* b2 = last ? nB : cB + (size_t)(t + 2) * kstep;
            const char* a3 = a2 + kstep; const char* b3 = b2 + kstep;
            if (last && has_next) S.a_ready(nxt);
            if constexpr (SP2) {
            PG8_LDB(B0, 0, 0); PG8_LDB(B1, 0, 1); PG8_SCHED; PG8_LDA(At, 0, 0); PG8_STAGE(PG8_SA(1, 1), a1 + hstep, voffA);
            PG8_WAIT_V(8); PG8_WAIT_L(0); PG8_BAR; PG8_MMA(0, 0, At, B0); PG8_MMA(0, 1, At, B1); PG8_BAR; PG8_SCHED;
            PG8_LDA(At, 0, 1); PG8_STAGE(PG8_SB(0, 0), b2, voffB); PG8_STAGE(PG8_SB(0, 1), b2 + hstep, voffB); PG8_STAGE(PG8_SA(0, 0), a2, voffA);
            PG8_WAIT_V(8); PG8_WAIT_L(0); PG8_BAR; PG8_MMA(1, 0, At, B0); PG8_MMA(1, 1, At, B1); PG8_BAR; PG8_SCHED;
            PG8_LDB(B0, 1, 0); PG8_LDB(B1, 1, 1); PG8_SCHED; PG8_LDA(At, 1, 0); PG8_STAGE(PG8_SA(0, 1), a2 + hstep, voffA);
            PG8_WAIT_V(8); PG8_WAIT_L(0); PG8_BAR; PG8_MMA(0, 0, At, B0); PG8_MMA(0, 1, At, B1); PG8_BAR; PG8_SCHED;
            PG8_LDA(At, 1, 1); PG8_STAGE(PG8_SB(1, 0), b3, voffB); PG8_STAGE(PG8_SB(1, 1), b3 + hstep, voffB); PG8_STAGE(PG8_SA(1, 0), a3, voffA);
            PG8_WAIT_V(8); PG8_WAIT_L(0); PG8_BAR; PG8_MMA(1, 0, At, B0); PG8_MMA(1, 1, At, B1); PG8_BAR; PG8_SCHED;
            } else {
            PG8_LDB(B0, 0, 0); PG8_SCHED; PG8_LDA(At, 0, 0); PG8_STAGE(PG8_SA(1, 1), a1 + hstep, voffA);
            PG8_WAIT_L(8); PG8_BAR; PG8_WAIT_L(0); PG8_MMA(0, 0, At, B0); PG8_BAR; PG8_SCHED;
            PG8_LDB(B1, 0, 1); PG8_STAGE(PG8_SB(0, 0), b2, voffB);
            PG8_BAR; PG8_WAIT_L(0); PG8_MMA(0, 1, At, B1); PG8_BAR;
            PG8_LDA(At, 0, 1); PG8_STAGE(PG8_SA(0, 0), a2, voffA);
            PG8_BAR; PG8_WAIT_L(0); PG8_MMA(1, 0, At, B0); PG8_BAR; PG8_SCHED;
            PG8_STAGE(PG8_SB(0, 1), b2 + hstep, voffB);
            PG8_WAIT_V(6); PG8_BAR; PG8_MMA(1, 1, At, B1); PG8_BAR;
            PG8_LDB(B0, 1, 0); PG8_SCHED; PG8_LDA(At, 1, 0); PG8_STAGE(PG8_SA(0, 1), a2 + hstep, voffA);
            PG8_WAIT_L(8); PG8_BAR; PG8_WAIT_L(0); PG8_MMA(0, 0, At, B0); PG8_BAR; PG8_SCHED;
            PG8_LDB(B1, 1, 1); PG8_STAGE(PG8_SB(1, 0), b3, voffB);
            PG8_BAR; PG8_WAIT_L(0); PG8_MMA(0, 1, At, B1); PG8_BAR;
            PG8_LDA(At, 1, 1); PG8_STAGE(PG8_SA(1, 0), a3, voffA);
            PG8_BAR; PG8_WAIT_L(0); PG8_MMA(1, 0, At, B0); PG8_BAR; PG8_SCHED;
            PG8_STAGE(PG8_SB(1, 1), b3 + hstep, voffB);
            PG8_WAIT_V(6); PG8_BAR; PG8_MMA(1, 1, At, B1); PG8_BAR;
            }
        }
        if constexpr (ALIGN_EPI) { if (wr == 0) PG8_BAR; }
        if constexpr (!Epi::AFTER_DRAIN) { E(acc, cur, wr, wc, fr, fq); S.done(cur); }
        if (!has_next) break;
#pragma unroll
        for (int a = 0; a < 2; ++a)
#pragma unroll
            for (int b = 0; b < 2; ++b)
#pragma unroll
                for (int m = 0; m < 4; ++m)
#pragma unroll
                    for (int n = 0; n < 2; ++n) acc[a][b][m][n] = (f32x4){0.f, 0.f, 0.f, 0.f};
        cur = nxt; cA = nA; cB = nB; ++ui;
        if constexpr (ALIGN_EPI) { if (wr == 1) PG8_BAR; }
    }
    PG8_WAIT_V(0);
    if constexpr (!ALIGN_EPI) { if (wr == 0) PG8_BAR; }
    PG8_BAR;
    if constexpr (Epi::AFTER_DRAIN) { E.fused(acc, cur, wr, wc, fr, fq, lds, wid, lane); S.done(cur); }
#undef PG8_SA
#undef PG8_SB
#undef PG8_STAGE
#undef PG8_LDA
#undef PG8_LDB
#undef PG8_MMA
#undef PG8_WAIT_V
#undef PG8_WAIT_L
#undef PG8_BAR
#undef PG8_SCHED
}
}

#ifndef PG8_SP2
#define PG8_SP2 true
#endif
#ifndef PG8_ALIGN
#define PG8_ALIGN true
#endif
#ifndef MK_N_LAUNCHES
#define MK_N_LAUNCHES 1
#endif
constexpr int N_LAUNCHES = MK_N_LAUNCHES;
constexpr int N_PHASES = 10;
#ifndef PROBE_DUP
#define PROBE_DUP 0
#endif
#ifndef PROBE_WHICH
#define PROBE_WHICH 1
#endif
#define DUP(k) ((PROBE_DUP >> (k)) & 1)

constexpr int NWAVES = 8;
constexpr int D = 4096, NB = 4, SEQ = 4096, NMETA = 16;
constexpr int MSEQ = NB * SEQ;
constexpr int MROWS = MSEQ + NMETA;
constexpr int MPAD = 65 * 256;
constexpr int IN_COLS = 14336, DFF = 11008, NUP = 2 * DFF;
constexpr int RET_H = 8, SB_H = 16;
constexpr int C_RQ = 0, C_RK = 2048, C_RV = 4096, C_RG = 6144, C_SQ = 8192, C_SK = 10240, C_SV = 12288;
constexpr float EPS = 1e-6f;

constexpr size_t MiB = 1u << 20;
constexpr size_t WS_CTL = 0, CTL_ZERO_BYTES = 1 * MiB;
constexpr size_t WS_WIN = 1 * MiB;
constexpr size_t WS_WOUT = WS_WIN + (size_t)IN_COLS * D * 2;
constexpr size_t WS_WUP = WS_WOUT + (size_t)D * D * 2;
constexpr size_t WS_WDOWN = WS_WUP + (size_t)NUP * D * 2;
constexpr size_t WS_XN = WS_WDOWN + (size_t)D * DFF * 2;
constexpr size_t WS_PROJ = WS_XN + (size_t)MPAD * D * 2;
constexpr size_t WS_ACT = WS_PROJ;
constexpr size_t WS_ABF = WS_PROJ;
constexpr size_t WS_META = WS_PROJ + (size_t)MPAD * IN_COLS * 2;
constexpr size_t WS_HALO = WS_META + (size_t)256 * D * 4;
constexpr size_t WS_FIRSTG = WS_HALO + (size_t)257 * 2 * DFF * 4;
constexpr size_t WS_FIRSTU = WS_FIRSTG + (size_t)256 * 2 * DFF * 4;
constexpr size_t WS_KST = WS_FIRSTU + (size_t)256 * 2 * DFF * 4;
constexpr size_t WS_VT = WS_KST + (size_t)NB * RET_H * 256 * pg8::PPR * 2;
constexpr size_t WS_SVT = WS_VT + (size_t)NB * RET_H * 256 * pg8::PPR * 2;
constexpr size_t WS_END = WS_SVT + (size_t)NB * SB_H * 128 * pg8::PPS * 2;
constexpr size_t WS_F = WS_WIN;
static_assert(WS_F + (size_t)MSEQ * D * 4 <= WS_WDOWN, "F overlay must not reach the w_down copy");
static_assert(WS_ACT + (size_t)MSEQ * DFF * 2 <= WS_META, "ACT overlay inside PROJ");
constexpr int CW_TMO = 0, CW_CODE = 1, CW_BAR = 4096;

constexpr int RING_OFF = 0, RING_BYTES = 131072;
constexpr int LDSCTL_OFF = RING_BYTES, MISC_OFF = LDSCTL_OFF + 320;
constexpr int LDS_BYTES = 147456;
constexpr int TS_OFF = LDSCTL_OFF + 1024;
static_assert(TS_OFF + 8 * 1536 <= LDS_BYTES, "LDS map");
static_assert(MISC_OFF + 128 <= LDS_BYTES, "LDS map");

#define GAS __attribute__((address_space(1)))
#define LAS __attribute__((address_space(3)))
typedef unsigned short bf16;
typedef unsigned v4u __attribute__((ext_vector_type(4)));
typedef unsigned v2u __attribute__((ext_vector_type(2)));
typedef float f32x4 __attribute__((ext_vector_type(4)));
typedef short bf16x8 __attribute__((ext_vector_type(8)));
typedef GAS unsigned gu32;
#define RLX_AGENT __ATOMIC_RELAXED, __HIP_MEMORY_SCOPE_AGENT
#define LDS_WAIT() asm volatile("s_waitcnt lgkmcnt(0)" ::: "memory")
#define VM_WAIT() asm volatile("s_waitcnt vmcnt(0)" ::: "memory")
__device__ __forceinline__ unsigned f2bf(float f) { unsigned u = __builtin_bit_cast(unsigned, f); return (u + 0x7fffu + ((u >> 16) & 1u)) >> 16; }
__device__ __forceinline__ unsigned pk2(float lo, float hi) { return f2bf(lo) | (f2bf(hi) << 16); }
__device__ __forceinline__ float bflo(unsigned w) { return __builtin_bit_cast(float, w << 16); }
__device__ __forceinline__ float bfhi(unsigned w) { return __builtin_bit_cast(float, w & 0xffff0000u); }

__device__ const float ROPE_REV[128] = {1.591549367e-01f, 1.481051445e-01f, 1.378225088e-01f, 1.282537580e-01f, 1.193493754e-01f, 1.110631898e-01f, 1.033523008e-01f, 9.617675841e-02f, 8.949939907e-02f, 8.328563720e-02f, 7.750329375e-02f, 7.212239504e-02f, 6.711508334e-02f, 6.245541945e-02f, 5.811926723e-02f, 5.408416688e-02f, 5.032921210e-02f, 4.683495313e-02f, 4.358330369e-02f, 4.055740312e-02f, 3.774158657e-02f, 3.512126580e-02f, 3.268286586e-02f, 3.041376360e-02f, 2.830219641e-02f, 2.633723244e-02f, 2.450869232e-02f, 2.280710265e-02f, 2.122365125e-02f, 1.975013874e-02f, 1.837892644e-02f, 1.710291393e-02f, 1.591549441e-02f, 1.481051464e-02f, 1.378224976e-02f, 1.282537542e-02f, 1.193493605e-02f, 1.110631879e-02f, 1.033523027e-02f, 9.617676027e-03f, 8.949940093e-03f, 8.328564465e-03f, 7.750329096e-03f, 7.212239318e-03f, 6.711508613e-03f, 6.245541386e-03f, 5.811926443e-03f, 5.408416502e-03f, 5.032920744e-03f, 4.683495499e-03f, 4.358330276e-03f, 4.055740312e-03f, 3.774158657e-03f, 3.512126161e-03f, 3.268286819e-03f, 3.041375894e-03f, 2.830219688e-03f, 2.633722965e-03f, 2.450869186e-03f, 2.280710265e-03f, 2.122365404e-03f, 1.975013874e-03f, 1.837892691e-03f, 1.710291486e-03f, 1.591549371e-03f, 1.481051324e-03f, 1.378225046e-03f, 1.282537705e-03f, 1.193493721e-03f, 1.110631856e-03f, 1.033522887e-03f, 9.617675678e-04f, 8.949940093e-04f, 8.328563999e-04f, 7.750329096e-04f, 7.212238852e-04f, 6.711508031e-04f, 6.245541736e-04f, 5.811926676e-04f, 5.408416619e-04f, 5.032921326e-04f, 4.683495790e-04f, 4.358330334e-04f, 4.055740428e-04f, 3.774158249e-04f, 3.512126568e-04f, 3.268286237e-04f, 3.041376185e-04f, 2.830219746e-04f, 2.633723198e-04f, 2.450869069e-04f, 2.280710323e-04f, 2.122365258e-04f, 1.975013729e-04f, 1.837892487e-04f, 1.710291544e-04f, 1.591549517e-04f, 1.481051440e-04f, 1.378224988e-04f, 1.282537705e-04f, 1.193493736e-04f, 1.110631856e-04f, 1.033523004e-04f, 9.617675823e-05f, 8.949940093e-05f, 8.328563854e-05f, 7.750328950e-05f, 7.212239143e-05f, 6.711508468e-05f, 6.245541590e-05f, 5.811926894e-05f, 5.408416473e-05f, 5.032921035e-05f, 4.683495354e-05f, 4.358330261e-05f, 4.055740283e-05f, 3.774158540e-05f, 3.512126204e-05f, 3.268286673e-05f, 3.041376112e-05f, 2.830219637e-05f, 2.633723307e-05f, 2.450869033e-05f, 2.280710214e-05f, 2.122365368e-05f, 1.975013765e-05f, 1.837892705e-05f, 1.710291508e-05f};


#define XB_TMO      128
#define XB_XCNT(j)  (256  + 64 * (j))
#define XB_XSUB(j)  (1280 + 64 * (j))
#define XB_XGEN(j)  (2304 + 64 * (j))
#define XB_TOP      3328
#define XB_TOPGEN   3392
#define XCD_BAR_WORDS 3456
#define XB_SPIN_CAP (1u << 22)

__device__ __forceinline__ unsigned xb_ld(unsigned* p)              { return __hip_atomic_load(p, __ATOMIC_RELAXED, __HIP_MEMORY_SCOPE_AGENT); }
__device__ __forceinline__ unsigned xb_add(unsigned* p, unsigned v) { return __hip_atomic_fetch_add(p, v, __ATOMIC_RELAXED, __HIP_MEMORY_SCOPE_AGENT); }
__device__ __forceinline__ unsigned xb_xcc_id() { return (unsigned)__builtin_amdgcn_s_getreg((3 << 11) | 20) & 0xFu; }
#define XB_SPIN(cond, bar) do { unsigned _sp = 0; while (cond) { __builtin_amdgcn_s_sleep(1); \
    if ((++_sp & 255u) == 0u) { if (xb_ld(&(bar)[XB_TMO])) break; if (_sp > XB_SPIN_CAP) { atomicAdd(&(bar)[XB_TMO], 1u); break; } } } } while (0)

struct XcdBarrier {
    unsigned* bar; unsigned x;
    volatile LAS unsigned* st;
};

__device__ __forceinline__ XcdBarrier xcd_barrier_post(unsigned* bar, volatile LAS unsigned* st) {
    XcdBarrier b; b.bar = bar; b.x = xb_xcc_id(); b.st = st;
    if (threadIdx.x == 0) (void)xb_add(&bar[XB_XCNT(b.x)], 1u);
    return b;
}
__device__ __forceinline__ void xcd_barrier_complete(unsigned* bar, unsigned x, unsigned& nloc, unsigned& nx) {
    const unsigned G = gridDim.x * gridDim.y * gridDim.z;
    unsigned sum, cnt, mine, sp = 0u;
    for (;;) {
        sum = 0u; cnt = 0u; mine = 0u;
#pragma unroll
        for (unsigned j = 0; j < 16; ++j) { const unsigned c = xb_ld(&bar[XB_XCNT(j)]); sum += c; cnt += (c > 0u) ? 1u : 0u; mine = (j == x) ? c : mine; }
        if (sum == G) break;
        __builtin_amdgcn_s_sleep(1);
        if ((++sp & 255u) == 0u) { if (xb_ld(&bar[XB_TMO])) break; if (sp > XB_SPIN_CAP) { atomicAdd(&bar[XB_TMO], 1u); break; } }
    }
    nloc = mine > 0u ? mine : 1u; nx = cnt > 0u ? cnt : 1u;
}

__device__ __forceinline__ void xcd_barrier(const XcdBarrier& b) {
    asm volatile("s_waitcnt vmcnt(0)" ::: "memory");
    __syncthreads();
    if (threadIdx.x == 0) {
        unsigned* bar = b.bar;
        __builtin_amdgcn_s_waitcnt(0);
        unsigned nloc = b.st[0], nx = b.st[1];
        if (nloc == 0u) { xcd_barrier_complete(bar, b.x, nloc, nx); b.st[0] = nloc; b.st[1] = nx; }
        const unsigned old = xb_add(&bar[XB_XSUB(b.x)], 1u);
        const unsigned gen = old / nloc;
        if (old + 1u == (gen + 1u) * nloc) {
            __builtin_amdgcn_fence(__ATOMIC_RELEASE, "agent");
            asm volatile("s_waitcnt vmcnt(0)" ::: "memory");
            const unsigned og = xb_add(&bar[XB_TOP], 1u);
            const unsigned tg = og / nx;
            if (og + 1u == (tg + 1u) * nx) xb_add(&bar[XB_TOPGEN], 1u);
            else XB_SPIN(xb_ld(&bar[XB_TOPGEN]) == tg, bar);
            __builtin_amdgcn_fence(__ATOMIC_ACQUIRE, "agent");
            xb_add(&bar[XB_XGEN(b.x)], 1u);
            asm volatile("s_waitcnt vmcnt(0)" ::: "memory");
        } else {
            XB_SPIN(xb_ld(&bar[XB_XGEN(b.x)]) == gen, bar);
            __builtin_amdgcn_fence(__ATOMIC_ACQUIRE, "agent");
            asm volatile("s_waitcnt vmcnt(0)" ::: "memory");
        }
    }
    __syncthreads();
}


struct Frame {
    LAS unsigned char* lds;
    volatile LAS unsigned* MISC;
    gu32* ctl;
    int tid, lane, wave, vcu, G;
    const float *x, *meta, *w_pre, *w_in, *gn_w, *sbn_w, *w_out, *w_post, *w_pre2, *w_up, *conv_w, *conv_b, *w_down, *w_post2;
    float* out;
    bf16 *WIN, *WOUT, *WUP, *WDOWN, *XN, *PROJ, *ACT, *KST, *VT, *SVT;
    float *META, *HALO, *FIRSTG, *FIRSTU; bf16 *Fb, *ABF;
};
__device__ __forceinline__ float wave_sum(float v) {
#pragma unroll
    for (int o = 1; o < 64; o <<= 1) v += __shfl_xor(v, o);
    return v;
}
__device__ __forceinline__ void p0_transpose_item(const float* W, int K, int N, bf16* WT, int k0, int n0, int dst0, LAS float* scr, int lane) {
#pragma unroll 8
    for (int i = 0; i < 32; ++i) { const int kk = 2 * i + (lane >> 5); scr[kk * 33 + (lane & 31)] = W[(size_t)(k0 + kk) * N + n0 + (lane & 31)]; }
    LDS_WAIT(); asm volatile("" ::: "memory");
    const int c = lane & 7;
#pragma unroll
    for (int j = 0; j < 4; ++j) { const int n = (lane >> 3) + 8 * j; const LAS float* s = scr + (8 * c) * 33 + n;
        v4u o; o.x = pk2(s[0 * 33], s[1 * 33]); o.y = pk2(s[2 * 33], s[3 * 33]); o.z = pk2(s[4 * 33], s[5 * 33]); o.w = pk2(s[6 * 33], s[7 * 33]);
        *(GAS v4u*)(WT + (size_t)(dst0 + n) * K + k0 + 8 * c) = o; }
    LDS_WAIT(); asm volatile("" ::: "memory");
}
__device__ __forceinline__ const float* h_row(Frame& F, int r) { return r < MSEQ ? F.x + (size_t)r * D : F.meta + (size_t)(r - MSEQ) * D; }

__device__ __forceinline__ void p0_prologue(Frame& F) {
    LAS float* scr = (LAS float*)(F.lds + RING_OFF + F.wave * 16384);
    const int gw = F.vcu * NWAVES + F.wave, NGW = F.G * NWAVES;
    constexpr int I_IN = (D / 64) * (IN_COLS / 32), I_OUT = (D / 64) * (D / 32), I_UP = (D / 64) * (NUP / 32), I_DN = (DFF / 64) * (D / 32);
    constexpr int NITEMS = I_IN + I_OUT + I_UP + I_DN;
    for (int it = gw; it < NITEMS; it += NGW) {
        int r = it;
        if (r < I_IN) { const int nb = IN_COLS / 32, kb = r / nb, n0 = 32 * (r % nb); p0_transpose_item(F.w_in, D, IN_COLS, F.WIN, 64 * kb, n0, n0, scr, F.lane); continue; } r -= I_IN;
        if (r < I_OUT) { const int nb = D / 32, kb = r / nb, n0 = 32 * (r % nb); p0_transpose_item(F.w_out, D, D, F.WOUT, 64 * kb, n0, n0, scr, F.lane); continue; } r -= I_OUT;
        if (r < I_UP) { const int nb = NUP / 32, kb = r / nb, n0 = 32 * (r % nb); const int up = n0 >= DFF, j = up ? n0 - DFF : n0;
            p0_transpose_item(F.w_up, D, NUP, F.WUP, 64 * kb, n0, (j >> 7) * 256 + up * 128 + (j & 127), scr, F.lane); continue; } r -= I_UP;
        { const int nb = D / 32, kb = r / nb, n0 = 32 * (r % nb); p0_transpose_item(F.w_down, DFF, D, F.WDOWN, 64 * kb, n0, n0, scr, F.lane); }
    }
    { const int gt = F.vcu * (NWAVES * 64) + F.tid, NGT = F.G * NWAVES * 64; constexpr int NR = NB * RET_H * 256;
        for (int i = gt; i < NR * 2; i += NGT) { const int r = i >> 1, q = i & 1; const v4u z = {0u, 0u, 0u, 0u};
            *(GAS v4u*)(F.KST + (size_t)r * pg8::PPR + 8 * q) = z; *(GAS v4u*)(F.VT + (size_t)r * pg8::PPR + 8 * q) = z; *(GAS v4u*)(F.SVT + (size_t)r * pg8::PPS + 4112 + 8 * q) = z; } }
    for (int m = gw; m < MROWS; m += NGW) {
        const GAS f32x4* xr = (const GAS f32x4*)h_row(F, m) + F.lane; const GAS f32x4* wr4 = (const GAS f32x4*)F.w_pre + F.lane;
        f32x4 v[16]; float s = 0.f;
#pragma unroll
        for (int j = 0; j < 16; ++j) { v[j] = xr[64 * j]; s += (v[j].x * v[j].x + v[j].y * v[j].y) + (v[j].z * v[j].z + v[j].w * v[j].w); }
        const float r = 1.0f / sqrtf(wave_sum(s) * (1.f / D) + EPS);
        GAS v2u* o8 = (GAS v2u*)(F.XN + (size_t)m * D) + F.lane;
#pragma unroll
        for (int j = 0; j < 16; ++j) { const f32x4 w = wr4[64 * j]; v2u o; o.x = pk2(v[j].x * r * w.x, v[j].y * r * w.y); o.y = pk2(v[j].z * r * w.z, v[j].w * r * w.w); o8[64 * j] = o; }
    }
}

__device__ __forceinline__ size_t pos_row(int b, int p) { return p < NMETA ? (size_t)(MSEQ + p) : (size_t)(b * SEQ + p - NMETA); }

typedef float f32x16 __attribute__((ext_vector_type(16)));
typedef short s16x4 __attribute__((ext_vector_type(4)));
__device__ __forceinline__ unsigned cvtpk(float lo, float hi) { return pg8::cvt_pk_bf16(lo, hi); }
__device__ __forceinline__ bf16x8 pack8(float a0, float a1, float a2, float a3, float a4, float a5, float a6, float a7) {
    v4u w; w.x = cvtpk(a0, a1); w.y = cvtpk(a2, a3); w.z = cvtpk(a4, a5); w.w = cvtpk(a6, a7); return __builtin_bit_cast(bf16x8, w); }
__device__ __forceinline__ bf16x8 cat8(v2u lo, v2u hi) { v4u w; w.x = lo.x; w.y = lo.y; w.z = hi.x; w.w = hi.y; return __builtin_bit_cast(bf16x8, w); }

constexpr int RET_NCH = 129, RET_BUF = 49152 + 4096;
__device__ __forceinline__ void ret_dma(Frame& F, LAS unsigned char* L, int b, int h, const bf16* KTg, const bf16* VTg, int c, int bufi) {
    const int lane = F.lane;
#pragma unroll
    for (int i = 0; i < 6; ++i) {
        const int q = F.wave + 8 * i, tile = i >> 1, j = q & 15;
        const bf16* src;
        if (tile < 2) { const int row = 2 * j + (lane >> 5), sc = (lane & 31) ^ (row & 15); int p = 32 * c + row - pg8::RPAD; p = p < 0 ? 0 : p;
            src = F.PROJ + pos_row(b, p) * IN_COLS + (tile ? C_RK : C_RQ) + h * 256 + 8 * sc; }
        else { const int d = 16 * j + (lane >> 2), gq = (lane & 3) ^ ((d >> 2) & 3); src = KTg + (size_t)d * pg8::PPR + 32 * c + 8 * gq; }
        __builtin_amdgcn_global_load_lds((const unsigned*)src, (LAS unsigned*)(L + bufi * RET_BUF + q * 1024), 16, 0, 0);
    }
    if (F.wave < 4)
        __builtin_amdgcn_global_load_lds((const unsigned*)(VTg + (size_t)(lane >> 2) * pg8::PPR + 32 * c + 8 * (lane & 3)), (LAS unsigned*)(L + bufi * RET_BUF + 49152 + F.wave * 1024), 16, 0, 0);
}
__device__ __forceinline__ void ret_group(Frame& F, int grp) {
    const int b = grp >> 5, h = (grp >> 2) & 7, lane = F.lane, li = lane & 15, g = lane >> 4;
    const bool comp = F.wave < 4; const int sl = 4 * (grp & 3) + (F.wave & 3);
    LAS unsigned char* L = F.lds + RING_OFF;
    const bf16* KTg = F.KST + (size_t)(b * RET_H + h) * 256 * pg8::PPR;
    const bf16* VTg = F.VT + ((size_t)(b * RET_H + h) * 256 + sl * 16) * pg8::PPR;
    const float lgh = __builtin_log2f(1.0f - __builtin_exp2f(-5.0f - (float)h)), cdec = __builtin_exp2f(32.0f * lgh);
    f32x4 St[16];
#pragma unroll
    for (int i = 0; i < 16; ++i) St[i] = (f32x4){0.f, 0.f, 0.f, 0.f};
    v2u pend0 = {0u, 0u}, pend1 = {0u, 0u};
    ret_dma(F, L, b, h, KTg, VTg, 0, 0);
    for (int c = 0; c < RET_NCH; ++c) {
        asm volatile("s_waitcnt vmcnt(0)" ::: "memory");
        if (comp && c > 0) {
            const int p0 = 32 * (c - 1) + li - pg8::RPAD, p1 = p0 + 16;
            if (p0 >= NMETA || (p0 >= 0 && b == 0)) *(GAS v2u*)(F.XN + pos_row(b, p0) * D + h * 256 + sl * 16 + 4 * g) = pend0;
            if (p1 >= NMETA || (p1 >= 0 && b == 0)) *(GAS v2u*)(F.XN + pos_row(b, p1) * D + h * 256 + sl * 16 + 4 * g) = pend1;
        }
        asm volatile("" ::: "memory"); __builtin_amdgcn_s_barrier(); asm volatile("" ::: "memory");
        if (c + 1 < RET_NCH) ret_dma(F, L, b, h, KTg, VTg, c + 1, (c + 1) & 1);
        if (comp) {
            const LAS unsigned char* base = L + (c & 1) * RET_BUF;
            const LAS unsigned char* vb = base + 49152 + F.wave * 1024 + li * 64;
            const v2u vfa = *(const LAS v2u*)(vb + 8 * g), vfb = *(const LAS v2u*)(vb + 32 + 8 * g); const bf16x8 Vn = *(const LAS bf16x8*)(vb + 16 * g);
            f32x4 ST0 = {0.f, 0.f, 0.f, 0.f}, ST1 = ST0, ST2 = ST0, OT0 = ST0, OT1 = ST0;
#pragma unroll
            for (int s = 0; s < 8; ++s) {
                bf16x8 Qf[2], Kf[2];
#pragma unroll
                for (int k = 0; k < 2; ++k) { const int row = 16 * k + li;
                    const int a0 = (row * 32 + ((4 * s + (g >> 1)) ^ li)) * 16 + 8 * (g & 1), a1 = (row * 32 + ((4 * s + 2 + (g >> 1)) ^ li)) * 16 + 8 * (g & 1);
                    Qf[k] = cat8(*(const LAS v2u*)(base + a0), *(const LAS v2u*)(base + a1));
                    Kf[k] = cat8(*(const LAS v2u*)(base + 16384 + a0), *(const LAS v2u*)(base + 16384 + a1)); }
                const bf16x8 SA = pack8(St[2 * s][0], St[2 * s][1], St[2 * s][2], St[2 * s][3], St[2 * s + 1][0], St[2 * s + 1][1], St[2 * s + 1][2], St[2 * s + 1][3]);
                ST0 = __builtin_amdgcn_mfma_f32_16x16x32_bf16(Kf[0], Qf[0], ST0, 0, 0, 0);
                ST1 = __builtin_amdgcn_mfma_f32_16x16x32_bf16(Kf[0], Qf[1], ST1, 0, 0, 0);
                ST2 = __builtin_amdgcn_mfma_f32_16x16x32_bf16(Kf[1], Qf[1], ST2, 0, 0, 0);
                OT0 = __builtin_amdgcn_mfma_f32_16x16x32_bf16(SA, Qf[0], OT0, 0, 0, 0);
                OT1 = __builtin_amdgcn_mfma_f32_16x16x32_bf16(SA, Qf[1], OT1, 0, 0, 0);
            }
#pragma unroll
            for (int r = 0; r < 4; ++r) if (4 * g + r > li) { ST0[r] = 0.f; ST2[r] = 0.f; }
            const bf16x8 Vf = cat8(vfa, vfb);
            OT0 = __builtin_amdgcn_mfma_f32_16x16x32_bf16(Vf, pack8(ST0[0], ST0[1], ST0[2], ST0[3], 0.f, 0.f, 0.f, 0.f), OT0, 0, 0, 0);
            OT1 = __builtin_amdgcn_mfma_f32_16x16x32_bf16(Vf, pack8(ST1[0], ST1[1], ST1[2], ST1[3], ST2[0], ST2[1], ST2[2], ST2[3]), OT1, 0, 0, 0);
            pend0.x = cvtpk(OT0[0], OT0[1]); pend0.y = cvtpk(OT0[2], OT0[3]); pend1.x = cvtpk(OT1[0], OT1[1]); pend1.y = cvtpk(OT1[2], OT1[3]);
#pragma unroll
            for (int db = 0; db < 16; ++db) { const int d = 16 * db + li;
                const bf16x8 Kt = *(const LAS bf16x8*)(base + 32768 + (d * 4 + (g ^ ((d >> 2) & 3))) * 16);
                St[db] = __builtin_amdgcn_mfma_f32_16x16x32_bf16(Kt, Vn, St[db], 0, 0, 0);
                St[db] = St[db] * cdec; }
        }
    }
    if (comp) {
        const int p0 = 32 * (RET_NCH - 1) + li - pg8::RPAD, p1 = p0 + 16;
        *(GAS v2u*)(F.XN + pos_row(b, p0) * D + h * 256 + sl * 16 + 4 * g) = pend0;
        *(GAS v2u*)(F.XN + pos_row(b, p1) * D + h * 256 + sl * 16 + 4 * g) = pend1;
    }
    asm volatile("s_waitcnt vmcnt(0)" ::: "memory"); __builtin_amdgcn_s_barrier();
}

__device__ __forceinline__ void sb_unit(Frame& F, int b, int hd, int i) {
    const int lane = F.lane, r32 = lane & 31, hh = lane >> 5;
    const int pq = 32 * i + r32; const bool qvalid = pq < SEQ + NMETA;
    const bf16* qrow = F.PROJ + pos_row(b, qvalid ? pq : SEQ + NMETA - 1) * IN_COLS + C_SQ + hd * 128 + 8 * hh;
    bf16x8 qf[8];
#pragma unroll
    for (int kk = 0; kk < 8; ++kk) qf[kk] = *(const GAS bf16x8*)(qrow + 16 * kk);
    f32x16 o[4];
#pragma unroll
    for (int c = 0; c < 4; ++c)
#pragma unroll
        for (int r = 0; r < 16; ++r) o[c][r] = 0.f;
    float R = 0.f;
    const bf16* svt = F.SVT + ((size_t)(b * SB_H + hd) * 128 + r32) * pg8::PPS + 8 * hh;
    const int kperm = (r32 & ~12) | ((r32 & 4) << 1) | ((r32 & 8) >> 1);
    for (int kb = i; kb >= 0; --kb) {
        const int pk = 32 * kb + kperm;
        const bf16* krow = F.PROJ + pos_row(b, pk < SEQ + NMETA ? pk : SEQ + NMETA - 1) * IN_COLS + C_SK + hd * 128 + 8 * hh;
        bf16x8 kf[8], vf[8];
#pragma unroll
        for (int kk = 0; kk < 8; ++kk) kf[kk] = *(const GAS bf16x8*)(krow + 16 * kk);
#pragma unroll
        for (int c = 0; c < 4; ++c)
#pragma unroll
            for (int ks = 0; ks < 2; ++ks) vf[c * 2 + ks] = *(const GAS bf16x8*)(svt + (size_t)(32 * c) * pg8::PPS + 32 * kb + 16 * ks);
        f32x16 sacc;
#pragma unroll
        for (int r = 0; r < 16; ++r) sacc[r] = 0.f;
#pragma unroll
        for (int kk = 0; kk < 8; ++kk) sacc = __builtin_amdgcn_mfma_f32_32x32x16_bf16(kf[kk], qf[kk], sacc, 0, 0, 0);
        float lk[16], zb[16]; bool vm[16];
#pragma unroll
        for (int r = 0; r < 16; ++r) {
            const float z = sacc[r];
            const float sp = fmaxf(z, 0.f) + __builtin_amdgcn_logf(1.0f + __builtin_amdgcn_exp2f(-fabsf(z)));
            vm[r] = (kb < i) || (16 * (r >> 3) + 8 * hh + (r & 7) < r32);
            lk[r] = vm[r] ? -sp : 0.f; zb[r] = z - sp;
        }
        float ghi = 0.f, glo = 0.f;
#pragma unroll
        for (int r = 0; r < 8; ++r) { glo += lk[r]; ghi += lk[8 + r]; }
        const float pghi = __shfl_xor(ghi, 32), pglo = __shfl_xor(glo, 32);
        const float Thi = ghi + pghi, Tlo = glo + pglo;
        float w[16];
        float run = R + (hh ? 0.f : pghi);
#pragma unroll
        for (int r = 15; r >= 8; --r) { w[r] = vm[r] ? __builtin_amdgcn_exp2f(zb[r] + run) : 0.f; run += lk[r]; }
        run = (R + Thi) + (hh ? 0.f : pglo);
#pragma unroll
        for (int r = 7; r >= 0; --r) { w[r] = vm[r] ? __builtin_amdgcn_exp2f(zb[r] + run) : 0.f; run += lk[r]; }
        R = (R + Thi) + Tlo;
        const bf16x8 pa0 = pack8(w[0], w[1], w[2], w[3], w[4], w[5], w[6], w[7]), pa1 = pack8(w[8], w[9], w[10], w[11], w[12], w[13], w[14], w[15]);
#pragma unroll
        for (int c = 0; c < 4; ++c) {
            o[c] = __builtin_amdgcn_mfma_f32_32x32x16_bf16(vf[c * 2 + 0], pa0, o[c], 0, 0, 0);
            o[c] = __builtin_amdgcn_mfma_f32_32x32x16_bf16(vf[c * 2 + 1], pa1, o[c], 0, 0, 0);
        }
        if (__all((R < -160.f) || !qvalid)) break;
    }
    float ss = 0.f;
#pragma unroll
    for (int c = 0; c < 4; ++c)
#pragma unroll
        for (int r = 0; r < 16; ++r) ss += o[c][r] * o[c][r];
    ss += __shfl_xor(ss, 32);
    const float rinv = 1.0f / sqrtf(ss * (1.f / 128.f) + EPS);
    {
        const float* wv = F.sbn_w + hd * 128 + 4 * hh;
        f32x4 wn[16];
#pragma unroll
        for (int k = 0; k < 16; ++k) wn[k] = *(const GAS f32x4*)(wv + 32 * (k >> 2) + 8 * (k & 3));
        if (qvalid && (b == 0 || pq >= NMETA)) {
            bf16* orow = F.XN + pos_row(b, pq) * D + 2048 + hd * 128 + 4 * hh;
#pragma unroll
            for (int c = 0; c < 4; ++c)
#pragma unroll
                for (int q4 = 0; q4 < 4; ++q4) {
                    const f32x4 w4 = wn[c * 4 + q4];
                    v2u ov; ov.x = cvtpk(o[c][4 * q4] * rinv * w4.x, o[c][4 * q4 + 1] * rinv * w4.y); ov.y = cvtpk(o[c][4 * q4 + 2] * rinv * w4.z, o[c][4 * q4 + 3] * rinv * w4.w);
                    *(GAS v2u*)(orow + 32 * c + 8 * q4) = ov;
                }
        }
    }
}

__device__ __forceinline__ void p2_mixers(Frame& F) {
    constexpr int NGRP = NB * RET_H * 4;
    constexpr int NSLAB = (SEQ + NMETA + 31) / 32;
    if (F.vcu < NGRP) ret_group(F, F.vcu);
    else for (int it = (F.vcu - NGRP) * NWAVES + F.wave; it < NB * SB_H * NSLAB; it += (F.G - NGRP) * NWAVES) { const int bh = it / NSLAB, sl = it % NSLAB; sb_unit(F, bh >> 4, bh & 15, sl); }
}

__device__ __forceinline__ void p3_retnorm(Frame& F) {
    const int gw = F.vcu * NWAVES + F.wave, NGW = F.G * NWAVES, lane = F.lane;
    for (int item = gw; item < RET_H * MROWS; item += NGW) {
        const int h = item & 7, rr = item >> 3;
        GAS v2u* yp = (GAS v2u*)(F.XN + (size_t)rr * D + h * 256 + 4 * lane);
        const v2u yv = *yp; const float o0 = bflo(yv.x), o1 = bfhi(yv.x), o2 = bflo(yv.y), o3 = bfhi(yv.y);
        const float ss = wave_sum(o0 * o0 + o1 * o1 + o2 * o2 + o3 * o3);
        const float r = 1.0f / sqrtf(ss * (1.f / 256.f) + EPS);
        const f32x4 gw4 = *(const GAS f32x4*)(F.gn_w + h * 256 + 4 * lane);
        const v2u gv = *(const GAS v2u*)(F.PROJ + (size_t)rr * IN_COLS + C_RG + h * 256 + 4 * lane);
        const float g0 = bflo(gv.x), g1 = bfhi(gv.x), g2 = bflo(gv.y), g3 = bfhi(gv.y);
        const float y0 = g0 / (1.f + __expf(-g0)) * (o0 * r * gw4.x), y1 = g1 / (1.f + __expf(-g1)) * (o1 * r * gw4.y);
        const float y2 = g2 / (1.f + __expf(-g2)) * (o2 * r * gw4.z), y3 = g3 / (1.f + __expf(-g3)) * (o3 * r * gw4.w);
        v2u ov; ov.x = pk2(y0, y1); ov.y = pk2(y2, y3); *yp = ov;
    }
}

__device__ __forceinline__ void p4_norms(Frame& F) {
    const int gw = F.vcu * NWAVES + F.wave, NGW = F.G * NWAVES;
    for (int m = gw; m < MROWS; m += NGW) {
        const GAS v2u* ab = (const GAS v2u*)(F.ABF + (size_t)m * D) + F.lane;
        GAS f32x4* h2 = (GAS f32x4*)(m < MSEQ ? F.out + (size_t)m * D : F.META + (size_t)(m - MSEQ) * D) + F.lane;
        const GAS f32x4* hr = (const GAS f32x4*)h_row(F, m) + F.lane;
        const GAS f32x4* wp = (const GAS f32x4*)F.w_post + F.lane; const GAS f32x4* wq = (const GAS f32x4*)F.w_pre2 + F.lane;
        f32x4 v[16]; float s = 0.f;
#pragma unroll
        for (int j = 0; j < 16; ++j) { const v2u a2 = ab[64 * j]; v[j] = (f32x4){bflo(a2.x), bfhi(a2.x), bflo(a2.y), bfhi(a2.y)}; s += (v[j].x * v[j].x + v[j].y * v[j].y) + (v[j].z * v[j].z + v[j].w * v[j].w); }
        const float r = 1.0f / sqrtf(wave_sum(s) * (1.f / D) + EPS); float s2 = 0.f;
#pragma unroll
        for (int j = 0; j < 16; ++j) { const f32x4 w = wp[64 * j], hv = hr[64 * j]; v[j] = hv + v[j] * r * w; h2[64 * j] = v[j]; s2 += (v[j].x * v[j].x + v[j].y * v[j].y) + (v[j].z * v[j].z + v[j].w * v[j].w); }
        const float r2 = 1.0f / sqrtf(wave_sum(s2) * (1.f / D) + EPS);
        GAS v2u* o8 = (GAS v2u*)(F.XN + (size_t)m * D) + F.lane;
#pragma unroll
        for (int j = 0; j < 16; ++j) { const f32x4 w = wq[64 * j]; v2u o; o.x = pk2(v[j].x * r2 * w.x, v[j].y * r2 * w.y); o.y = pk2(v[j].z * r2 * w.z, v[j].w * r2 * w.w); o8[64 * j] = o; }
    }
}

__device__ __forceinline__ void p6_fixup(Frame& F) {
    const int gt = F.vcu * (NWAVES * 64) + F.tid, NGT = F.G * NWAVES * 64;
    constexpr int QC = DFF / 4;
    for (int i = gt; i < 256 * QC; i += NGT) {
        const int sg = i / QC, jq = i % QC, j = 4 * jq;
        const int prev = (sg & 63) == 0 ? 256 : sg - 1;
        const f32x4 h0 = *(const GAS f32x4*)(F.HALO + ((size_t)prev * 2 + 0) * DFF + j), h1 = *(const GAS f32x4*)(F.HALO + ((size_t)prev * 2 + 1) * DFF + j);
        const f32x4 g0 = *(const GAS f32x4*)(F.FIRSTG + ((size_t)sg * 2 + 0) * DFF + j), g1 = *(const GAS f32x4*)(F.FIRSTG + ((size_t)sg * 2 + 1) * DFF + j);
        const f32x4 u0 = *(const GAS f32x4*)(F.FIRSTU + ((size_t)sg * 2 + 0) * DFF + j), u1 = *(const GAS f32x4*)(F.FIRSTU + ((size_t)sg * 2 + 1) * DFF + j);
        const f32x4 w0 = *(const GAS f32x4*)(F.conv_w + j), w1 = *(const GAS f32x4*)(F.conv_w + DFF + j), w2 = *(const GAS f32x4*)(F.conv_w + 2 * DFF + j), bb = *(const GAS f32x4*)(F.conv_b + j);
        float a0[4], a1[4];
#pragma unroll
        for (int e = 0; e < 4; ++e) {
            const float c0 = bb[e] + w0[e] * h0[e] + w1[e] * h1[e] + w2[e] * g0[e];
            const float c1 = bb[e] + w0[e] * h1[e] + w1[e] * g0[e] + w2[e] * g1[e];
            a0[e] = c0 / (1.f + __expf(-c0)) * u0[e]; a1[e] = c1 / (1.f + __expf(-c1)) * u1[e];
        }
        v2u o; o.x = pk2(a0[0], a0[1]); o.y = pk2(a0[2], a0[3]); *(GAS v2u*)(F.ACT + (size_t)(sg * 64) * DFF + j) = o;
        o.x = pk2(a1[0], a1[1]); o.y = pk2(a1[2], a1[3]); *(GAS v2u*)(F.ACT + (size_t)(sg * 64 + 1) * DFF + j) = o;
    }
}

__device__ __forceinline__ void p8_final(Frame& F) {
    const int gw = F.vcu * NWAVES + F.wave, NGW = F.G * NWAVES;
    for (int m = gw; m < MSEQ; m += NGW) {
        GAS f32x4* orow = (GAS f32x4*)(F.out + (size_t)m * D) + F.lane; const GAS v2u* fr = (const GAS v2u*)(F.Fb + (size_t)m * D) + F.lane;
        const GAS f32x4* wp = (const GAS f32x4*)F.w_post2 + F.lane;
        f32x4 v[16], hv[16]; float s = 0.f;
#pragma unroll
        for (int j = 0; j < 16; ++j) { const v2u a2 = fr[64 * j]; hv[j] = orow[64 * j]; v[j] = (f32x4){bflo(a2.x), bfhi(a2.x), bflo(a2.y), bfhi(a2.y)}; s += (v[j].x * v[j].x + v[j].y * v[j].y) + (v[j].z * v[j].z + v[j].w * v[j].w); }
        const float r = 1.0f / sqrtf(wave_sum(s) * (1.f / D) + EPS);
#pragma unroll
        for (int j = 0; j < 16; ++j) { const f32x4 w = wp[64 * j]; orow[64 * j] = hv[j] + v[j] * r * w; }
    }
}

struct Args { const float* in[14]; float* out; unsigned char* ws; int ph_lo, ph_hi; };
__global__ void __launch_bounds__(NWAVES * 64, 2) hymba_fwd(Args args) {
    extern __shared__ __attribute__((aligned(16))) unsigned char lds[];
    Frame F;
    F.lds = (LAS unsigned char*)lds;
    F.MISC = (volatile LAS unsigned*)(F.lds + MISC_OFF);
    F.tid = threadIdx.x; F.lane = F.tid & 63; F.wave = __builtin_amdgcn_readfirstlane(F.tid >> 6);
    F.G = gridDim.x; { const int bx = blockIdx.x; F.vcu = (F.G % 8 == 0) ? (bx % 8) * (F.G / 8) + bx / 8 : bx; }
    unsigned char* ws = args.ws;
    F.ctl = (gu32*)(ws + WS_CTL);
    F.x = args.in[0]; F.meta = args.in[1]; F.w_pre = args.in[2]; F.w_in = args.in[3]; F.gn_w = args.in[4]; F.sbn_w = args.in[5]; F.w_out = args.in[6]; F.w_post = args.in[7];
    F.w_pre2 = args.in[8]; F.w_up = args.in[9]; F.conv_w = args.in[10]; F.conv_b = args.in[11]; F.w_down = args.in[12]; F.w_post2 = args.in[13]; F.out = args.out;
    F.WIN = (bf16*)(ws + WS_WIN); F.WOUT = (bf16*)(ws + WS_WOUT); F.WUP = (bf16*)(ws + WS_WUP); F.WDOWN = (bf16*)(ws + WS_WDOWN); F.XN = (bf16*)(ws + WS_XN);
    F.PROJ = (bf16*)(ws + WS_PROJ); F.ACT = (bf16*)(ws + WS_ACT); F.META = (float*)(ws + WS_META); F.HALO = (float*)(ws + WS_HALO); F.FIRSTG = (float*)(ws + WS_FIRSTG);
    F.FIRSTU = (float*)(ws + WS_FIRSTU); F.Fb = (bf16*)(ws + WS_F); F.ABF = (bf16*)(ws + WS_ABF); F.KST = (bf16*)(ws + WS_KST); F.VT = (bf16*)(ws + WS_VT); F.SVT = (bf16*)(ws + WS_SVT);
    for (int u = F.tid; u < (LDS_BYTES - LDSCTL_OFF) / 4; u += NWAVES * 64) ((LAS unsigned*)(F.lds + LDSCTL_OFF))[u] = 0u;
    __syncthreads();
    XcdBarrier bar; bar.bar = (unsigned*)(F.ctl + CW_BAR); bar.x = 0; bar.st = nullptr;
    if (N_LAUNCHES == 1) bar = xcd_barrier_post((unsigned*)(F.ctl + CW_BAR), F.MISC + 8);
#define GRID_BAR() do { if (N_LAUNCHES == 1) xcd_barrier(bar); } while (0)
    const int lo = args.ph_lo, hi = args.ph_hi;
#define IN(k) (lo <= (k) && (k) < hi)
#define BOTH(k) (IN(k) && IN((k) + 1))

    if (IN(0)) for (int rep_ = 0; rep_ <= DUP(0); ++rep_) { p0_prologue(F); if (BOTH(0)) GRID_BAR(); }
    if (IN(1)) for (int rep_ = 0; rep_ <= DUP(1); ++rep_) {
        pg8::Gemm g{F.XN, F.WIN, MPAD, IN_COLS, D}; pg8::StaticOrder S; S.init(MPAD, IN_COLS, F.G, (int)blockIdx.x);
        pg8::EpiProj E{F.PROJ, IN_COLS, ROPE_REV, F.KST, F.VT, F.SVT, F.lds + TS_OFF};
        pg8::gemm_phase<pg8::EpiProj, pg8::StaticOrder, PG8_ALIGN, PG8_SP2>(F.lds + RING_OFF, g, S, E);
        if (BOTH(1)) GRID_BAR();
    }
    if (IN(2)) for (int rep_ = 0; rep_ <= DUP(2); ++rep_) { p2_mixers(F); if (BOTH(2)) GRID_BAR(); }
    if (IN(3)) { p3_retnorm(F); if (BOTH(3)) GRID_BAR(); }
    if (IN(4)) for (int rep_ = 0; rep_ <= DUP(4); ++rep_) {
        pg8::Gemm g{F.XN, F.WOUT, MPAD, D, D}; pg8::StaticOrder S; S.init(MPAD, D, F.G, (int)blockIdx.x);
        pg8::EpiBf16Plain E{F.ABF, D};
        pg8::gemm_phase<pg8::EpiBf16Plain, pg8::StaticOrder, PG8_ALIGN, PG8_SP2>(F.lds + RING_OFF, g, S, E);
        if (BOTH(4)) GRID_BAR();
    }
    if (IN(5)) { p4_norms(F); if (BOTH(5)) GRID_BAR(); }
    if (IN(6)) for (int rep_ = 0; rep_ <= DUP(6); ++rep_) {
        pg8::Gemm g{F.XN, F.WUP, MPAD, NUP, D}; pg8::StaticOrder S; S.init(MPAD, NUP, F.G, (int)blockIdx.x);
        pg8::EpiConv E{F.ACT, F.HALO, F.FIRSTG, F.FIRSTU, F.conv_w, F.conv_b, DFF};
        pg8::gemm_phase<pg8::EpiConv, pg8::StaticOrder, PG8_ALIGN, PG8_SP2>(F.lds + RING_OFF, g, S, E);
        if (BOTH(6)) GRID_BAR();
    }
    if (IN(7)) { p6_fixup(F); if (BOTH(7)) GRID_BAR(); }
    if (IN(8)) for (int rep_ = 0; rep_ <= DUP(8); ++rep_) {
        pg8::Gemm g{F.ACT, F.WDOWN, MSEQ, D, DFF}; pg8::StaticOrder S; S.init(MSEQ, D, F.G, (int)blockIdx.x);
        pg8::EpiBf16Plain E{F.Fb, D};
        pg8::gemm_phase<pg8::EpiBf16Plain, pg8::StaticOrder, PG8_ALIGN, PG8_SP2>(F.lds + RING_OFF, g, S, E);
        if (BOTH(8)) GRID_BAR();
    }
    if (IN(9)) { p8_final(F); }
#undef IN
#undef BOTH
}

extern "C" void kernel_launch(void* const* d_in, const int* in_sizes, int n_in, void* d_out, int out_size, void* d_ws, size_t ws_size, hipStream_t stream) {
    static int grid = 0;
    if (grid == 0) {
        if (n_in != 14 || out_size != MSEQ * D || ws_size < WS_END) { fprintf(stderr, "kernel_launch: unexpected shapes (n_in %d, out %d, ws %zu < %zu)\n", n_in, out_size, ws_size, (size_t)WS_END); grid = -1; return; }
        int dev = 0, cus = 0, per_cu = 0;
        if (hipGetDevice(&dev) != hipSuccess || hipDeviceGetAttribute(&cus, hipDeviceAttributeMultiprocessorCount, dev) != hipSuccess) { grid = -1; return; }
        if (hipFuncSetAttribute((const void*)hymba_fwd, hipFuncAttributeMaxDynamicSharedMemorySize, LDS_BYTES) != hipSuccess) { fprintf(stderr, "kernel_launch: hipFuncSetAttribute failed\n"); grid = -1; return; }
        if (hipOccupancyMaxActiveBlocksPerMultiprocessor(&per_cu, (const void*)hymba_fwd, NWAVES * 64, LDS_BYTES) != hipSuccess || per_cu < 1) fprintf(stderr, "kernel_launch: occupancy query reports %d\n", per_cu);
        (void)hipGetLastError();
        grid = cus;
    }
    if (grid < 0) return;
    if (hipMemsetAsync((char*)d_ws + WS_CTL, 0, CTL_ZERO_BYTES, stream) != hipSuccess) return;
    Args a{};
    for (int i = 0; i < 14; ++i) a.in[i] = (const float*)d_in[i];
    a.out = (float*)d_out; a.ws = (unsigned char*)d_ws;
    if (N_LAUNCHES == 1) { a.ph_lo = 0; a.ph_hi = N_PHASES; hipLaunchKernelGGL(hymba_fwd, dim3(grid), dim3(NWAVES * 64), LDS_BYTES, stream, a); }
    else for (int p = 0; p < N_PHASES; ++p) { a.ph_lo = p; a.ph_hi = p + 1; hipLaunchKernelGGL(hymba_fwd, dim3(grid), dim3(NWAVES * 64), LDS_BYTES, stream, a); }
    const hipError_t le = hipPeekAtLastError();
    if (le != hipSuccess) fprintf(stderr, "kernel_launch: launch failed: %s\n", hipGetErrorName(le));
}
```

```cpp
#include <hip/hip_runtime.h>
#include <cstdio>
#include <cstdint>
namespace pg8 {
#define PG8_LAS __attribute__((address_space(3)))
typedef unsigned short bf16_t;
typedef short bf16x8 __attribute__((ext_vector_type(8)));
typedef float f32x4 __attribute__((ext_vector_type(4)));
typedef unsigned u32x4 __attribute__((ext_vector_type(4)));
constexpr int BM = 256, BK = 64, HALF = 128, HTB = HALF * BK * 2  , STAGE_BYTES = 8 * HTB, NXCD = 8, WGM = 8;

__host__ __device__ __forceinline__ int lds_byte(int r, int c) { const int st = (r >> 4) * 2 + (c >> 5), rr = r & 15, cc = c & 31, ob = rr * 64 + cc * 2; return st * 1024 + (ob ^ (((ob >> 9) & 1) << 5)); }
__host__ __device__ __forceinline__ void stage_rc(int b, int& R, int& C) { const int st = b / 1024, sb = b % 1024, swz = sb ^ (((sb >> 9) & 1) << 5); R = (st >> 1) * 16 + swz / 64; C = (st & 1) * 32 + (swz % 64) / 2; }
__host__ __device__ __forceinline__ int perm32(int rho) { const int n = rho >> 4, i = rho & 15; return 8 * (i >> 2) + 4 * n + (i & 3); }

struct Unit { int pm, pn; };
struct Gemm { const bf16_t* A; const bf16_t* Bt; int M, N, K; };

struct StaticOrder {
    int nM, nN, nwg, G, c;
    __host__ __device__ void init(int M, int N, int G_, int c_) { nM = M / BM; nN = N / BM; nwg = nM * nN; G = G_; c = c_; }
    __host__ __device__ bool next(int i, Unit& u) const {
        const long L = (long)i * G + c; if (L >= nwg) return false;
        int wgid = (int)L; { const int q = nwg / NXCD, r = nwg % NXCD, xcd = wgid % NXCD, off = wgid / NXCD; wgid = (xcd < r ? xcd * (q + 1) : r * (q + 1) + (xcd - r) * q) + off; }
        const int nig = WGM * nN, gid = wgid / nig, fm = gid * WGM, gsz = (nM - fm) < WGM ? (nM - fm) : WGM;
        u.pm = fm + ((wgid % nig) % gsz); u.pn = (wgid % nig) / gsz; return true;
    }
    __device__ __forceinline__ void a_ready(const Unit&) const {}
    __device__ __forceinline__ void done(const Unit&) const {}
};

typedef float f32x2_t __attribute__((ext_vector_type(2))); typedef __bf16 bf16x2_t __attribute__((ext_vector_type(2)));
__device__ __forceinline__ unsigned cvt_pk_bf16(float lo, float hi) { f32x2_t v = {lo, hi}; bf16x2_t b = __builtin_convertvector(v, bf16x2_t); return __builtin_bit_cast(unsigned, b); }

constexpr int PPR = 4128, PPS = 4128, RPAD = 16, RCH = 32;
struct EpiProj {
    static constexpr bool PERM = true, AFTER_DRAIN = false;
    bf16_t* O; int ldc; const float* rope_rev; bf16_t* KST; bf16_t* VT; bf16_t* SVT; PG8_LAS unsigned char* tsl;
    __device__ __forceinline__ void tstore_lds(PG8_LAS unsigned char* scr, const u32x4 w, bf16_t* base, int H, int Dh, int PP, int hd, int d0, int row_base, int padoff, int lane) const {
        *(PG8_LAS u32x4*)(scr + (lane & 15) * 80 + (lane >> 4) * 16) = w;
        asm volatile("s_waitcnt lgkmcnt(0)" ::: "memory");
        const int c = lane & 31, rh = lane >> 5;
        const PG8_LAS unsigned short* rp = (const PG8_LAS unsigned short*)(scr + (8 * rh) * 80 + c * 2);
        u32x4 t; t.x = (unsigned)rp[0] | ((unsigned)rp[40] << 16); t.y = (unsigned)rp[80] | ((unsigned)rp[120] << 16); t.z = (unsigned)rp[160] | ((unsigned)rp[200] << 16); t.w = (unsigned)rp[240] | ((unsigned)rp[280] << 16);
        asm volatile("s_waitcnt lgkmcnt(0)" ::: "memory");
        if (row_base < 16384) { *(u32x4*)(base + ((size_t)((row_base >> 12) * H + hd) * Dh + d0 + c) * PP + (row_base & 4095) + 16 + padoff + 8 * rh) = t; }
        else if (row_base == 16384) {
#pragma unroll
            for (int b = 0; b < 4; ++b) *(u32x4*)(base + ((size_t)(b * H + hd) * Dh + d0 + c) * PP + padoff + 8 * rh) = t; }
    }
    __device__ __forceinline__ void operator()(const f32x4 (&acc)[2][2][4][2], const Unit& u, int wr, int wc, int fr, int fq) const {
        const int row0 = u.pm * BM + wr * 64 + fr, cl = wc * 32 + 8 * fq, col0 = u.pn * BM + cl, pn = u.pn, lane = fq * 16 + fr;
        PG8_LAS unsigned char* scr = tsl + (wr * 4 + wc) * 1536;
        if (pn < 16) {
            const f32x4 iv0 = *(const f32x4*)(rope_rev + cl), iv1 = *(const f32x4*)(rope_rev + cl + 4);
            const int h = pn & 7; const float lgh = __builtin_log2f(1.0f - __builtin_exp2f(-5.0f - (float)h));
#pragma unroll
            for (int ai = 0; ai < 2; ++ai)
#pragma unroll
                for (int m = 0; m < 4; ++m) {
                    const int row = row0 + ai * HALF + m * 16;
                    const int p = row < 16384 ? (row & 4095) + 16 : row - 16384;
                    const float pos = (float)p, ml = (float)((p + RPAD) & (RCH - 1));
                    const float sc = pn < 8 ? 0.0625f * __builtin_exp2f(ml * lgh) : __builtin_exp2f(-ml * lgh);
                    bf16_t* rowp = O + (size_t)row * ldc + col0;
                    float o0[8], o1[8];
#pragma unroll
                    for (int n = 0; n < 2; ++n)
#pragma unroll
                        for (int j = 0; j < 4; ++j) {
                            float t = pos * (n ? iv1[j] : iv0[j]); t = t - floorf(t);
                            const float sn = __builtin_amdgcn_sinf(t), cs = __builtin_amdgcn_cosf(t);
                            const float x1 = acc[ai][0][m][n][j], x2 = acc[ai][1][m][n][j];
                            o0[n * 4 + j] = (x1 * cs - x2 * sn) * sc; o1[n * 4 + j] = (x1 * sn + x2 * cs) * sc;
                        }
                    u32x4 w0, w1; w0.x = cvt_pk_bf16(o0[0], o0[1]); w0.y = cvt_pk_bf16(o0[2], o0[3]); w0.z = cvt_pk_bf16(o0[4], o0[5]); w0.w = cvt_pk_bf16(o0[6], o0[7]);
                    *(u32x4*)(rowp) = w0;
                    w1.x = cvt_pk_bf16(o1[0], o1[1]); w1.y = cvt_pk_bf16(o1[2], o1[3]); w1.z = cvt_pk_bf16(o1[4], o1[5]); w1.w = cvt_pk_bf16(o1[6], o1[7]);
                    *(u32x4*)(rowp + HALF) = w1;
                    if (pn >= 8) { const int rb = u.pm * BM + ai * HALF + wr * 64 + m * 16;
                        tstore_lds(scr, w0, KST, 8, 256, PPR, h, wc * 32, rb, RPAD, lane); tstore_lds(scr, w1, KST, 8, 256, PPR, h, HALF + wc * 32, rb, RPAD, lane); }
                }
        } else if (pn < 24 || pn >= 48) {
            const bool isr = pn < 24;
#pragma unroll
            for (int ai = 0; ai < 2; ++ai)
#pragma unroll
                for (int m = 0; m < 4; ++m) {
                    const int rb = u.pm * BM + ai * HALF + wr * 64 + m * 16;
#pragma unroll
                    for (int bj = 0; bj < 2; ++bj) {
                        const f32x4 v0 = acc[ai][bj][m][0], v1 = acc[ai][bj][m][1];
                        u32x4 w; w.x = cvt_pk_bf16(v0[0], v0[1]); w.y = cvt_pk_bf16(v0[2], v0[3]); w.z = cvt_pk_bf16(v1[0], v1[1]); w.w = cvt_pk_bf16(v1[2], v1[3]);
                        if (isr) tstore_lds(scr, w, VT, 8, 256, PPR, pn - 16, bj * HALF + wc * 32, rb, RPAD, lane);
                        else tstore_lds(scr, w, SVT, 16, 128, PPS, 2 * (pn - 48) + bj, wc * 32, rb, 0, lane);
                    }
                }
        } else {
            const float sc = (pn >= 32 && pn < 40) ? 0.12751743082459868f : 1.0f;
#pragma unroll
            for (int ai = 0; ai < 2; ++ai)
#pragma unroll
                for (int m = 0; m < 4; ++m) { bf16_t* rowp = O + (size_t)(row0 + ai * HALF + m * 16) * ldc + col0;
#pragma unroll
                    for (int bj = 0; bj < 2; ++bj) { const f32x4 v0 = acc[ai][bj][m][0] * sc, v1 = acc[ai][bj][m][1] * sc;
                        u32x4 w; w.x = cvt_pk_bf16(v0[0], v0[1]); w.y = cvt_pk_bf16(v0[2], v0[3]); w.z = cvt_pk_bf16(v1[0], v1[1]); w.w = cvt_pk_bf16(v1[2], v1[3]);
                        *(u32x4*)(rowp + bj * HALF) = w; } }
        }
    }
};

struct EpiBf16Plain {
    static constexpr bool PERM = true, AFTER_DRAIN = false;
    bf16_t* O; int ldc;
    __device__ __forceinline__ void operator()(const f32x4 (&acc)[2][2][4][2], const Unit& u, int wr, int wc, int fr, int fq) const {
        const int row0 = u.pm * BM + wr * 64 + fr, col0 = u.pn * BM + wc * 32 + 8 * fq;
#pragma unroll
        for (int ai = 0; ai < 2; ++ai)
#pragma unroll
            for (int m = 0; m < 4; ++m) { bf16_t* rowp = O + (size_t)(row0 + ai * HALF + m * 16) * ldc + col0;
#pragma unroll
                for (int bj = 0; bj < 2; ++bj) { const f32x4 v0 = acc[ai][bj][m][0], v1 = acc[ai][bj][m][1];
                    u32x4 w; w.x = cvt_pk_bf16(v0[0], v0[1]); w.y = cvt_pk_bf16(v0[2], v0[3]); w.z = cvt_pk_bf16(v1[0], v1[1]); w.w = cvt_pk_bf16(v1[2], v1[3]);
                    *(u32x4*)(rowp + bj * HALF) = w; } }
    }
};

struct EpiF32Split {
    static constexpr bool PERM = false, AFTER_DRAIN = false;
    float* C0; float* C1; int rows0; int ldc;
    __device__ __forceinline__ void operator()(const f32x4 (&acc)[2][2][4][2], const Unit& u, int wr, int wc, int fr, int fq) const {
        const int row0 = u.pm * BM + wr * 64 + fr, col0 = u.pn * BM + wc * 32 + 4 * fq;
        float* base = row0 < rows0 ? C0 + (size_t)row0 * ldc : C1 + (size_t)(row0 - rows0) * ldc;
#pragma unroll
        for (int ai = 0; ai < 2; ++ai)
#pragma unroll
            for (int m = 0; m < 4; ++m) { float* rowp = base + (size_t)(ai * HALF + m * 16) * ldc + col0;
#pragma unroll
                for (int bj = 0; bj < 2; ++bj)
#pragma unroll
                    for (int n = 0; n < 2; ++n) *(f32x4*)(rowp + bj * HALF + n * 16) = acc[ai][bj][m][n]; }
    }
};

struct EpiConv {
    static constexpr bool PERM = true, AFTER_DRAIN = false;
    bf16_t* ACT; float* HALO; float* FIRSTG; float* FIRSTU; const float* cw; const float* cb; int dff;
    __device__ __forceinline__ void operator()(const f32x4 (&acc)[2][2][4][2], const Unit& u, int wr, int wc, int fr, int fq) const {
        const int lane = fq * 16 + fr, j0 = u.pn * HALF + wc * 32 + 8 * fq;
        if (u.pm == 64) {
            if (wr == 0 && fr >= 14) { float* hp = HALO + ((size_t)256 * 2 + (fr - 14)) * dff + j0; *(f32x4*)hp = acc[0][0][0][0]; *(f32x4*)(hp + 4) = acc[0][0][0][1]; }
            return;
        }
        f32x4 w0[2], w1[2], w2[2], bb[2];
#pragma unroll
        for (int n = 0; n < 2; ++n) { w0[n] = *(const f32x4*)(cw + j0 + 4 * n); w1[n] = *(const f32x4*)(cw + dff + j0 + 4 * n); w2[n] = *(const f32x4*)(cw + 2 * dff + j0 + 4 * n); bb[n] = *(const f32x4*)(cb + j0 + 4 * n); }
#pragma unroll
        for (int ai = 0; ai < 2; ++ai) {
            const int sg = u.pm * 4 + ai * 2 + wr;
#pragma unroll
            for (int m = 0; m < 4; ++m) {
                const int row = u.pm * BM + ai * HALF + wr * 64 + m * 16 + fr;
                float o[8];
#pragma unroll
                for (int n = 0; n < 2; ++n)
#pragma unroll
                    for (int j = 0; j < 4; ++j) {
                        const float g = acc[ai][0][m][n][j], gp = m > 0 ? acc[ai][0][m > 0 ? m - 1 : 0][n][j] : 0.f;
                        const float snd1 = fr == 15 ? gp : g, snd2 = fr >= 14 ? gp : g;
                        const float x1 = __builtin_bit_cast(float, __builtin_amdgcn_update_dpp(0, __builtin_bit_cast(int, snd1), 0x121, 0xf, 0xf, false));
                        const float x2 = __builtin_bit_cast(float, __builtin_amdgcn_update_dpp(0, __builtin_bit_cast(int, snd2), 0x122, 0xf, 0xf, false));
                        const float cv = bb[n][j] + w0[n][j] * x2 + w1[n][j] * x1 + w2[n][j] * g;
                        const float sl = cv * __builtin_amdgcn_rcpf(1.0f + __builtin_amdgcn_exp2f(-1.4426950408889634f * cv));
                        o[n * 4 + j] = sl * acc[ai][1][m][n][j];
                    }
                if (m == 0 && fr < 2) {
                    float* gpz = FIRSTG + ((size_t)sg * 2 + fr) * dff + j0; float* upz = FIRSTU + ((size_t)sg * 2 + fr) * dff + j0;
                    *(f32x4*)gpz = acc[ai][0][0][0]; *(f32x4*)(gpz + 4) = acc[ai][0][0][1]; *(f32x4*)upz = acc[ai][1][0][0]; *(f32x4*)(upz + 4) = acc[ai][1][0][1];
                } else {
                    u32x4 w; w.x = cvt_pk_bf16(o[0], o[1]); w.y = cvt_pk_bf16(o[2], o[3]); w.z = cvt_pk_bf16(o[4], o[5]); w.w = cvt_pk_bf16(o[6], o[7]);
                    *(u32x4*)(ACT + (size_t)row * dff + j0) = w;
                }
                if (m == 3 && fr >= 14) { float* hp = HALO + ((size_t)sg * 2 + (fr - 14)) * dff + j0; *(f32x4*)hp = acc[ai][0][3][0]; *(f32x4*)(hp + 4) = acc[ai][0][3][1]; }
            }
        }
    }
};

template <class Epi, class Sched, bool ALIGN_EPI = false, bool SP2 = false>
__device__ __forceinline__ void gemm_phase(PG8_LAS unsigned char* lds, const Gemm g, const Sched& S, const Epi& E) {
    const int tid = threadIdx.x, wid = __builtin_amdgcn_readfirstlane(tid >> 6), lane = tid & 63, wr = wid >> 2, wc = wid & 3, fr = lane & 15, fq = lane >> 4;
    const int K = g.K, nt = K / BK;
    unsigned voffA[2], voffB[2];
#pragma unroll
    for (int i = 0; i < 2; ++i) { int R, C; stage_rc(tid * 16 + i * 8192, R, C); const int Rb = Epi::PERM ? ((R & ~31) + perm32(R & 31)) : R;
        voffA[i] = (unsigned)(R * K + C) * 2u; voffB[i] = (unsigned)(Rb * K + C) * 2u; }
    const size_t kstep = (size_t)(BK * 2);
    const size_t hstep = (size_t)HALF * K * 2;
    const size_t tstep = 2 * hstep;
    const unsigned ldsw = (unsigned)wid * 1024u;
    const int aoff = lds_byte(wr * 64 + fr, fq * 8), boff = lds_byte(wc * 32 + fr, fq * 8);
#define PG8_SA(b, h) (((b) * 2 + (h)) * HTB)
#define PG8_SB(b, h) ((4 + (b) * 2 + (h)) * HTB)
#define PG8_STAGE(bufoff, gbase, voff) do { _Pragma("unroll") for (int _i = 0; _i < 2; ++_i) \
        __builtin_amdgcn_global_load_lds((const unsigned*)((const char*)(gbase) + (voff)[_i]), (PG8_LAS unsigned*)(lds + (bufoff) + ldsw + _i * 8192), 16, 0, 0); } while (0)
#define PG8_LDA(dst, b, h) do { _Pragma("unroll") for (int m = 0; m < 4; ++m) _Pragma("unroll") for (int k = 0; k < 2; ++k) dst[m][k] = *(const PG8_LAS bf16x8*)(lds + PG8_SA(b, h) + aoff + m * 2048 + k * 1024); } while (0)
#define PG8_LDB(dst, b, h) do { _Pragma("unroll") for (int n = 0; n < 2; ++n) _Pragma("unroll") for (int k = 0; k < 2; ++k) dst[n][k] = *(const PG8_LAS bf16x8*)(lds + PG8_SB(b, h) + boff + n * 2048 + k * 1024); } while (0)
#define PG8_MMA(ai, bj, At, Bt) do { __builtin_amdgcn_s_setprio(1); _Pragma("unroll") for (int m = 0; m < 4; ++m) _Pragma("unroll") for (int n = 0; n < 2; ++n) _Pragma("unroll") for (int k = 0; k < 2; ++k) \
        acc[ai][bj][m][n] = __builtin_amdgcn_mfma_f32_16x16x32_bf16(Bt[n][k], At[m][k], acc[ai][bj][m][n], 0, 0, 0); __builtin_amdgcn_s_setprio(0); } while (0)
#define PG8_WAIT_V(n) asm volatile("s_waitcnt vmcnt(" #n ")" ::: "memory")
#define PG8_WAIT_L(n) asm volatile("s_waitcnt lgkmcnt(" #n ")" ::: "memory")
#define PG8_BAR __builtin_amdgcn_s_barrier()
#define PG8_SCHED __builtin_amdgcn_sched_barrier(0)
    Unit cur, nxt; int ui = 0;
    if (!S.next(0, cur)) return;
    f32x4 acc[2][2][4][2];
#pragma unroll
    for (int a = 0; a < 2; ++a)
#pragma unroll
        for (int b = 0; b < 2; ++b)
#pragma unroll
            for (int m = 0; m < 4; ++m)
#pragma unroll
                for (int n = 0; n < 2; ++n) acc[a][b][m][n] = (f32x4){0.f, 0.f, 0.f, 0.f};
    bf16x8 At[4][2], B0[2][2], B1[2][2];
    const char* cA = (const char*)g.A + (size_t)cur.pm * tstep; const char* cB = (const char*)g.Bt + (size_t)cur.pn * tstep;
    S.a_ready(cur);
    if constexpr (SP2) {
        PG8_STAGE(PG8_SB(0, 0), cB, voffB); PG8_STAGE(PG8_SB(0, 1), cB + hstep, voffB); PG8_STAGE(PG8_SA(0, 0), cA, voffA); PG8_STAGE(PG8_SA(0, 1), cA + hstep, voffA);
        if (wr == 1) PG8_BAR;
        PG8_WAIT_V(2); PG8_BAR;
        PG8_STAGE(PG8_SB(1, 0), cB + kstep, voffB); PG8_STAGE(PG8_SA(1, 0), cA + kstep, voffA); PG8_STAGE(PG8_SB(1, 1), cB + hstep + kstep, voffB);
        PG8_WAIT_V(6); PG8_BAR;
    } else {
        PG8_STAGE(PG8_SB(0, 0), cB, voffB); PG8_STAGE(PG8_SA(0, 0), cA, voffA); PG8_STAGE(PG8_SB(0, 1), cB + hstep, voffB); PG8_STAGE(PG8_SA(0, 1), cA + hstep, voffA);
        if (wr == 1) PG8_BAR;
        PG8_WAIT_V(4); PG8_BAR;
        PG8_STAGE(PG8_SB(1, 0), cB + kstep, voffB); PG8_STAGE(PG8_SA(1, 0), cA + kstep, voffA); PG8_STAGE(PG8_SB(1, 1), cB + hstep + kstep, voffB);
        PG8_WAIT_V(6); PG8_BAR;
    }
    for (;;) {
        const bool has_next = S.next(ui + 1, nxt);
        const char* nA = has_next ? (const char*)g.A + (size_t)nxt.pm * tstep : cA; const char* nB = has_next ? (const char*)g.Bt + (size_t)nxt.pn * tstep : cB;
        for (int t = 0; t < nt; t += 2) {
            const bool last = (t == nt - 2);
            const char* a1 = cA + (size_t)(t + 1) * kstep;
            const char* a2 = last ? nA : cA + (size_t)(t + 2) * kstep; const char* b2 = last ? nB : cB + (size_t)(t + 2) * kstep;
            const char* a3 = a2 + kstep; const char* b3 = b2 + kstep;
            if (last && has_next) S.a_ready(nxt);
            if constexpr (SP2) {
            PG8_LDB(B0, 0, 0); PG8_LDB(B1, 0, 1); PG8_SCHED; PG8_LDA(At, 0, 0); PG8_STAGE(PG8_SA(1, 1), a1 + hstep, voffA);
            PG8_WAIT_V(8); PG8_WAIT_L(0); PG8_BAR; PG8_MMA(0, 0, At, B0); PG8_MMA(0, 1, At, B1); PG8_BAR; PG8_SCHED;
            PG8_LDA(At, 0, 1); PG8_STAGE(PG8_SB(0, 0), b2, voffB); PG8_STAGE(PG8_SB(0, 1), b2 + hstep, voffB); PG8_STAGE(PG8_SA(0, 0), a2, voffA);
            PG8_WAIT_V(8); PG8_WAIT_L(0); PG8_BAR; PG8_MMA(1, 0, At, B0); PG8_MMA(1, 1, At, B1); PG8_BAR; PG8_SCHED;
            PG8_LDB(B0, 1, 0); PG8_LDB(B1, 1, 1); PG8_SCHED; PG8_LDA(At, 1, 0); PG8_STAGE(PG8_SA(0, 1), a2 + hstep, voffA);
            PG8_WAIT_V(8); PG8_WAIT_L(0); PG8_BAR; PG8_MMA(0, 0, At, B0); PG8_MMA(0, 1, At, B1); PG8_BAR; PG8_SCHED;
            PG8_LDA(At, 1, 1); PG8_STAGE(PG8_SB(1, 0), b3, voffB); PG8_STAGE(PG8_SB(1, 1), b3 + hstep, voffB); PG8_STAGE(PG8_SA(1, 0), a3, voffA);
            PG8_WAIT_V(8); PG8_WAIT_L(0); PG8_BAR; PG8_MMA(1, 0, At, B0); PG8_MMA(1, 1, At, B1); PG8_BAR; PG8_SCHED;
            } else {
            PG8_LDB(B0, 0, 0); PG8_SCHED; PG8_LDA(At, 0, 0); PG8_STAGE(PG8_SA(1, 1), a1 + hstep, voffA);
            PG8_WAIT_L(8); PG8_BAR; PG8_WAIT_L(0); PG8_MMA(0, 0, At, B0); PG8_BAR; PG8_SCHED;
            PG8_LDB(B1, 0, 1); PG8_STAGE(PG8_SB(0, 0), b2, voffB);
            PG8_BAR; PG8_WAIT_L(0); PG8_MMA(0, 1, At, B1); PG8_BAR;
            PG8_LDA(At, 0, 1); PG8_STAGE(PG8_SA(0, 0), a2, voffA);
            PG8_BAR; PG8_WAIT_L(0); PG8_MMA(1, 0, At, B0); PG8_BAR; PG8_SCHED;
            PG8_STAGE(PG8_SB(0, 1), b2 + hstep, voffB);
            PG8_WAIT_V(6); PG8_BAR; PG8_MMA(1, 1, At, B1); PG8_BAR;
            PG8_LDB(B0, 1, 0); PG8_SCHED; PG8_LDA(At, 1, 0); PG8_STAGE(PG8_SA(0, 1), a2 + hstep, voffA);
            PG8_WAIT_L(8); PG8_BAR; PG8_WAIT_L(0); PG8_MMA(0, 0, At, B0); PG8_BAR; PG8_SCHED;
            PG8_LDB(B1, 1, 1); PG8_STAGE(PG8_SB(1, 0), b3, voffB);
            PG8_BAR; PG8_WAIT_L(0); PG8_MMA(0, 1, At, B1); PG8_BAR;
            PG8_LDA(At, 1, 1); PG8_STAGE(PG8_SA(1, 0), a3, voffA);
            PG8_BAR; PG8_WAIT_L(0); PG8_MMA(1, 0, At, B0); PG8_BAR; PG8_SCHED;
            PG8_STAGE(PG8_SB(1, 1), b3 + hstep, voffB);
            PG8_WAIT_V(6); PG8_BAR; PG8_MMA(1, 1, At, B1); PG8_BAR;
            }
        }
        if constexpr (ALIGN_EPI) { if (wr == 0) PG8_BAR; }
        if constexpr (!Epi::AFTER_DRAIN) { E(acc, cur, wr, wc, fr, fq); S.done(cur); }
        if (!has_next) break;
#pragma unroll
        for (int a = 0; a < 2; ++a)
#pragma unroll
            for (int b = 0; b < 2; ++b)
#pragma unroll
                for (int m = 0; m < 4; ++m)
#pragma unroll
                    for (int n = 0; n < 2; ++n) acc[a][b][m][n] = (f32x4){0.f, 0.f, 0.f, 0.f};
        cur = nxt; cA = nA; cB = nB; ++ui;
        if constexpr (ALIGN_EPI) { if (wr == 1) PG8_BAR; }
    }
    PG8_WAIT_V(0);
    if constexpr (!ALIGN_EPI) { if (wr == 0) PG8_BAR; }
    PG8_BAR;
    if constexpr (Epi::AFTER_DRAIN) { E.fused(acc, cur, wr, wc, fr, fq, lds, wid, lane); S.done(cur); }
#undef PG8_SA
#undef PG8_SB
#undef PG8_STAGE
#undef PG8_LDA
#undef PG8_LDB
#undef PG8_MMA
#undef PG8_WAIT_V
#undef PG8_WAIT_L
#undef PG8_BAR
#undef PG8_SCHED
}
}

#ifndef PG8_SP2
#define PG8_SP2 true
#endif
#ifndef PG8_ALIGN
#define PG8_ALIGN true
#endif
#ifndef MK_N_LAUNCHES
#define MK_N_LAUNCHES 1
#endif
constexpr int N_LAUNCHES = MK_N_LAUNCHES;
constexpr int N_PHASES = 10;
#ifndef PROBE_DUP
#define PROBE_DUP 0
#endif
#ifndef PROBE_WHICH
#define PROBE_WHICH 1
#endif
#define DUP(k) ((PROBE_DUP >> (k)) & 1)

constexpr int NWAVES = 8;
constexpr int D = 4096, NB = 4, SEQ = 4096, NMETA = 16;
constexpr int MSEQ = NB * SEQ;
constexpr int MROWS = MSEQ + NMETA;
constexpr int MPAD = 65 * 256;
constexpr int IN_COLS = 14336, DFF = 11008, NUP = 2 * DFF;
constexpr int RET_H = 8, SB_H = 16;
constexpr int C_RQ = 0, C_RK = 2048, C_RV = 4096, C_RG = 6144, C_SQ = 8192, C_SK = 10240, C_SV = 12288;
constexpr float EPS = 1e-6f;

constexpr size_t MiB = 1u << 20;
constexpr size_t WS_CTL = 0, CTL_ZERO_BYTES = 1 * MiB;
constexpr size_t WS_WIN = 1 * MiB;
constexpr size_t WS_WOUT = WS_WIN + (size_t)IN_COLS * D * 2;
constexpr size_t WS_WUP = WS_WOUT + (size_t)D * D * 2;
constexpr size_t WS_WDOWN = WS_WUP + (size_t)NUP * D * 2;
constexpr size_t WS_XN = WS_WDOWN + (size_t)D * DFF * 2;
constexpr size_t WS_PROJ = WS_XN + (size_t)MPAD * D * 2;
constexpr size_t WS_ACT = WS_PROJ;
constexpr size_t WS_ABF = WS_PROJ;
constexpr size_t WS_META = WS_PROJ + (size_t)MPAD * IN_COLS * 2;
constexpr size_t WS_HALO = WS_META + (size_t)256 * D * 4;
constexpr size_t WS_FIRSTG = WS_HALO + (size_t)257 * 2 * DFF * 4;
constexpr size_t WS_FIRSTU = WS_FIRSTG + (size_t)256 * 2 * DFF * 4;
constexpr size_t WS_KST = WS_FIRSTU + (size_t)256 * 2 * DFF * 4;
constexpr size_t WS_VT = WS_KST + (size_t)NB * RET_H * 256 * pg8::PPR * 2;
constexpr size_t WS_SVT = WS_VT + (size_t)NB * RET_H * 256 * pg8::PPR * 2;
constexpr size_t WS_END = WS_SVT + (size_t)NB * SB_H * 128 * pg8::PPS * 2;
constexpr size_t WS_F = WS_WIN;
static_assert(WS_F + (size_t)MSEQ * D * 4 <= WS_WDOWN, "F overlay must not reach the w_down copy");
static_assert(WS_ACT + (size_t)MSEQ * DFF * 2 <= WS_META, "ACT overlay inside PROJ");
constexpr int CW_TMO = 0, CW_CODE = 1, CW_BAR = 4096;

constexpr int RING_OFF = 0, RING_BYTES = 131072;
constexpr int LDSCTL_OFF = RING_BYTES, MISC_OFF = LDSCTL_OFF + 320;
constexpr int LDS_BYTES = 147456;
constexpr int TS_OFF = LDSCTL_OFF + 1024;
static_assert(TS_OFF + 8 * 1536 <= LDS_BYTES, "LDS map");
static_assert(MISC_OFF + 128 <= LDS_BYTES, "LDS map");

#define GAS __attribute__((address_space(1)))
#define LAS __attribute__((address_space(3)))
typedef unsigned short bf16;
typedef unsigned v4u __attribute__((ext_vector_type(4)));
typedef unsigned v2u __attribute__((ext_vector_type(2)));
typedef float f32x4 __attribute__((ext_vector_type(4)));
typedef short bf16x8 __attribute__((ext_vector_type(8)));
typedef GAS unsigned gu32;
#define RLX_AGENT __ATOMIC_RELAXED, __HIP_MEMORY_SCOPE_AGENT
#define LDS_WAIT() asm volatile("s_waitcnt lgkmcnt(0)" ::: "memory")
#define VM_WAIT() asm volatile("s_waitcnt vmcnt(0)" ::: "memory")
__device__ __forceinline__ unsigned f2bf(float f) { unsigned u = __builtin_bit_cast(unsigned, f); return (u + 0x7fffu + ((u >> 16) & 1u)) >> 16; }
__device__ __forceinline__ unsigned pk2(float lo, float hi) { return f2bf(lo) | (f2bf(hi) << 16); }
__device__ __forceinline__ float bflo(unsigned w) { return __builtin_bit_cast(float, w << 16); }
__device__ __forceinline__ float bfhi(unsigned w) { return __builtin_bit_cast(float, w & 0xffff0000u); }

__device__ const float ROPE_REV[128] = {1.591549367e-01f, 1.481051445e-01f, 1.378225088e-01f, 1.282537580e-01f, 1.193493754e-01f, 1.110631898e-01f, 1.033523008e-01f, 9.617675841e-02f, 8.949939907e-02f, 8.328563720e-02f, 7.750329375e-02f, 7.212239504e-02f, 6.711508334e-02f, 6.245541945e-02f, 5.811926723e-02f, 5.408416688e-02f, 5.032921210e-02f, 4.683495313e-02f, 4.358330369e-02f, 4.055740312e-02f, 3.774158657e-02f, 3.512126580e-02f, 3.268286586e-02f, 3.041376360e-02f, 2.830219641e-02f, 2.633723244e-02f, 2.450869232e-02f, 2.280710265e-02f, 2.122365125e-02f, 1.975013874e-02f, 1.837892644e-02f, 1.710291393e-02f, 1.591549441e-02f, 1.481051464e-02f, 1.378224976e-02f, 1.282537542e-02f, 1.193493605e-02f, 1.110631879e-02f, 1.033523027e-02f, 9.617676027e-03f, 8.949940093e-03f, 8.328564465e-03f, 7.750329096e-03f, 7.212239318e-03f, 6.711508613e-03f, 6.245541386e-03f, 5.811926443e-03f, 5.408416502e-03f, 5.032920744e-03f, 4.683495499e-03f, 4.358330276e-03f, 4.055740312e-03f, 3.774158657e-03f, 3.512126161e-03f, 3.268286819e-03f, 3.041375894e-03f, 2.830219688e-03f, 2.633722965e-03f, 2.450869186e-03f, 2.280710265e-03f, 2.122365404e-03f, 1.975013874e-03f, 1.837892691e-03f, 1.710291486e-03f, 1.591549371e-03f, 1.481051324e-03f, 1.378225046e-03f, 1.282537705e-03f, 1.193493721e-03f, 1.110631856e-03f, 1.033522887e-03f, 9.617675678e-04f, 8.949940093e-04f, 8.328563999e-04f, 7.750329096e-04f, 7.212238852e-04f, 6.711508031e-04f, 6.245541736e-04f, 5.811926676e-04f, 5.408416619e-04f, 5.032921326e-04f, 4.683495790e-04f, 4.358330334e-04f, 4.055740428e-04f, 3.774158249e-04f, 3.512126568e-04f, 3.268286237e-04f, 3.041376185e-04f, 2.830219746e-04f, 2.633723198e-04f, 2.450869069e-04f, 2.280710323e-04f, 2.122365258e-04f, 1.975013729e-04f, 1.837892487e-04f, 1.710291544e-04f, 1.591549517e-04f, 1.481051440e-04f, 1.378224988e-04f, 1.282537705e-04f, 1.193493736e-04f, 1.110631856e-04f, 1.033523004e-04f, 9.617675823e-05f, 8.949940093e-05f, 8.328563854e-05f, 7.750328950e-05f, 7.212239143e-05f, 6.711508468e-05f, 6.245541590e-05f, 5.811926894e-05f, 5.408416473e-05f, 5.032921035e-05f, 4.683495354e-05f, 4.358330261e-05f, 4.055740283e-05f, 3.774158540e-05f, 3.512126204e-05f, 3.268286673e-05f, 3.041376112e-05f, 2.830219637e-05f, 2.633723307e-05f, 2.450869033e-05f, 2.280710214e-05f, 2.122365368e-05f, 1.975013765e-05f, 1.837892705e-05f, 1.710291508e-05f};


#define XB_TMO      128
#define XB_XCNT(j)  (256  + 64 * (j))
#define XB_XSUB(j)  (1280 + 64 * (j))
#define XB_XGEN(j)  (2304 + 64 * (j))
#define XB_TOP      3328
#define XB_TOPGEN   3392
#define XCD_BAR_WORDS 3456
#define XB_SPIN_CAP (1u << 22)

__device__ __forceinline__ unsigned xb_ld(unsigned* p)              { return __hip_atomic_load(p, __ATOMIC_RELAXED, __HIP_MEMORY_SCOPE_AGENT); }
__device__ __forceinline__ unsigned xb_add(unsigned* p, unsigned v) { return __hip_atomic_fetch_add(p, v, __ATOMIC_RELAXED, __HIP_MEMORY_SCOPE_AGENT); }
__device__ __forceinline__ unsigned xb_xcc_id() { return (unsigned)__builtin_amdgcn_s_getreg((3 << 11) | 20) & 0xFu; }
#define XB_SPIN(cond, bar) do { unsigned _sp = 0; while (cond) { __builtin_amdgcn_s_sleep(1); \
    if ((++_sp & 255u) == 0u) { if (xb_ld(&(bar)[XB_TMO])) break; if (_sp > XB_SPIN_CAP) { atomicAdd(&(bar)[XB_TMO], 1u); break; } } } } while (0)

struct XcdBarrier {
    unsigned* bar; unsigned x;
    volatile LAS unsigned* st;
};

__device__ __forceinline__ XcdBarrier xcd_barrier_post(unsigned* bar, volatile LAS unsigned* st) {
    XcdBarrier b; b.bar = bar; b.x = xb_xcc_id(); b.st = st;
    if (threadIdx.x == 0) (void)xb_add(&bar[XB_XCNT(b.x)], 1u);
    return b;
}
__device__ __forceinline__ void xcd_barrier_complete(unsigned* bar, unsigned x, unsigned& nloc, unsigned& nx) {
    const unsigned G = gridDim.x * gridDim.y * gridDim.z;
    unsigned sum, cnt, mine, sp = 0u;
    for (;;) {
        sum = 0u; cnt = 0u; mine = 0u;
#pragma unroll
        for (unsigned j = 0; j < 16; ++j) { const unsigned c = xb_ld(&bar[XB_XCNT(j)]); sum += c; cnt += (c > 0u) ? 1u : 0u; mine = (j == x) ? c : mine; }
        if (sum == G) break;
        __builtin_amdgcn_s_sleep(1);
        if ((++sp & 255u) == 0u) { if (xb_ld(&bar[XB_TMO])) break; if (sp > XB_SPIN_CAP) { atomicAdd(&bar[XB_TMO], 1u); break; } }
    }
    nloc = mine > 0u ? mine : 1u; nx = cnt > 0u ? cnt : 1u;
}

__device__ __forceinline__ void xcd_barrier(const XcdBarrier& b) {
    asm volatile("s_waitcnt vmcnt(0)" ::: "memory");
    __syncthreads();
    if (threadIdx.x == 0) {
        unsigned* bar = b.bar;
        __builtin_amdgcn_s_waitcnt(0);
        unsigned nloc = b.st[0], nx = b.st[1];
        if (nloc == 0u) { xcd_barrier_complete(bar, b.x, nloc, nx); b.st[0] = nloc; b.st[1] = nx; }
        const unsigned old = xb_add(&bar[XB_XSUB(b.x)], 1u);
        const unsigned gen = old / nloc;
        if (old + 1u == (gen + 1u) * nloc) {
            __builtin_amdgcn_fence(__ATOMIC_RELEASE, "agent");
            asm volatile("s_waitcnt vmcnt(0)" ::: "memory");
            const unsigned og = xb_add(&bar[XB_TOP], 1u);
            const unsigned tg = og / nx;
            if (og + 1u == (tg + 1u) * nx) xb_add(&bar[XB_TOPGEN], 1u);
            else XB_SPIN(xb_ld(&bar[XB_TOPGEN]) == tg, bar);
            __builtin_amdgcn_fence(__ATOMIC_ACQUIRE, "agent");
            xb_add(&bar[XB_XGEN(b.x)], 1u);
            asm volatile("s_waitcnt vmcnt(0)" ::: "memory");
        } else {
            XB_SPIN(xb_ld(&bar[XB_XGEN(b.x)]) == gen, bar);
            __builtin_amdgcn_fence(__ATOMIC_ACQUIRE, "agent");
            asm volatile("s_waitcnt vmcnt(0)" ::: "memory");
        }
    }
    __syncthreads();
}


struct Frame {
    LAS unsigned char* lds;
    volatile LAS unsigned* MISC;
    gu32* ctl;
    int tid, lane, wave, vcu, G;
    const float *x, *meta, *w_pre, *w_in, *gn_w, *sbn_w, *w_out, *w_post, *w_pre2, *w_up, *conv_w, *conv_b, *w_down, *w_post2;
    float* out;
    bf16 *WIN, *WOUT, *WUP, *WDOWN, *XN, *PROJ, *ACT, *KST, *VT, *SVT;
    float *META, *HALO, *FIRSTG, *FIRSTU; bf16 *Fb, *ABF;
};
__device__ __forceinline__ float wave_sum(float v) {
#pragma unroll
    for (int o = 1; o < 64; o <<= 1) v += __shfl_xor(v, o);
    return v;
}
__device__ __forceinline__ void p0_transpose_item(const float* W, int K, int N, bf16* WT, int k0, int n0, int dst0, LAS float* scr, int lane) {
#pragma unroll 8
    for (int i = 0; i < 32; ++i) { const int kk = 2 * i + (lane >> 5); scr[kk * 33 + (lane & 31)] = W[(size_t)(k0 + kk) * N + n0 + (lane & 31)]; }
    LDS_WAIT(); asm volatile("" ::: "memory");
    const int c = lane & 7;
#pragma unroll
    for (int j = 0; j < 4; ++j) { const int n = (lane >> 3) + 8 * j; const LAS float* s = scr + (8 * c) * 33 + n;
        v4u o; o.x = pk2(s[0 * 33], s[1 * 33]); o.y = pk2(s[2 * 33], s[3 * 33]); o.z = pk2(s[4 * 33], s[5 * 33]); o.w = pk2(s[6 * 33], s[7 * 33]);
        *(GAS v4u*)(WT + (size_t)(dst0 + n) * K + k0 + 8 * c) = o; }
    LDS_WAIT(); asm volatile("" ::: "memory");
}
__device__ __forceinline__ const float* h_row(Frame& F, int r) { return r < MSEQ ? F.x + (size_t)r * D : F.meta + (size_t)(r - MSEQ) * D; }

__device__ __forceinline__ void p0_prologue(Frame& F) {
    LAS float* scr = (LAS float*)(F.lds + RING_OFF + F.wave * 16384);
    const int gw = F.vcu * NWAVES + F.wave, NGW = F.G * NWAVES;
    constexpr int I_IN = (D / 64) * (IN_COLS / 32), I_OUT = (D / 64) * (D / 32), I_UP = (D / 64) * (NUP / 32), I_DN = (DFF / 64) * (D / 32);
    constexpr int NITEMS = I_IN + I_OUT + I_UP + I_DN;
    for (int it = gw; it < NITEMS; it += NGW) {
        int r = it;
        if (r < I_IN) { const int nb = IN_COLS / 32, kb = r / nb, n0 = 32 * (r % nb); p0_transpose_item(F.w_in, D, IN_COLS, F.WIN, 64 * kb, n0, n0, scr, F.lane); continue; } r -= I_IN;
        if (r < I_OUT) { const int nb = D / 32, kb = r / nb, n0 = 32 * (r % nb); p0_transpose_item(F.w_out, D, D, F.WOUT, 64 * kb, n0, n0, scr, F.lane); continue; } r -= I_OUT;
        if (r < I_UP) { const int nb = NUP / 32, kb = r / nb, n0 = 32 * (r % nb); const int up = n0 >= DFF, j = up ? n0 - DFF : n0;
            p0_transpose_item(F.w_up, D, NUP, F.WUP, 64 * kb, n0, (j >> 7) * 256 + up * 128 + (j & 127), scr, F.lane); continue; } r -= I_UP;
        { const int nb = D / 32, kb = r / nb, n0 = 32 * (r % nb); p0_transpose_item(F.w_down, DFF, D, F.WDOWN, 64 * kb, n0, n0, scr, F.lane); }
    }
    { const int gt = F.vcu * (NWAVES * 64) + F.tid, NGT = F.G * NWAVES * 64; constexpr int NR = NB * RET_H * 256;
        for (int i = gt; i < NR * 2; i += NGT) { const int r = i >> 1, q = i & 1; const v4u z = {0u, 0u, 0u, 0u};
            *(GAS v4u*)(F.KST + (size_t)r * pg8::PPR + 8 * q) = z; *(GAS v4u*)(F.VT + (size_t)r * pg8::PPR + 8 * q) = z; *(GAS v4u*)(F.SVT + (size_t)r * pg8::PPS + 4112 + 8 * q) = z; } }
    for (int m = gw; m < MROWS; m += NGW) {
        const GAS f32x4* xr = (const GAS f32x4*)h_row(F, m) + F.lane; const GAS f32x4* wr4 = (const GAS f32x4*)F.w_pre + F.lane;
        f32x4 v[16]; float s = 0.f;
#pragma unroll
        for (int j = 0; j < 16; ++j) { v[j] = xr[64 * j]; s += (v[j].x * v[j].x + v[j].y * v[j].y) + (v[j].z * v[j].z + v[j].w * v[j].w); }
        const float r = 1.0f / sqrtf(wave_sum(s) * (1.f / D) + EPS);
        GAS v2u* o8 = (GAS v2u*)(F.XN + (size_t)m * D) + F.lane;
#pragma unroll
        for (int j = 0; j < 16; ++j) { const f32x4 w = wr4[64 * j]; v2u o; o.x = pk2(v[j].x * r * w.x, v[j].y * r * w.y); o.y = pk2(v[j].z * r * w.z, v[j].w * r * w.w); o8[64 * j] = o; }
    }
}

typedef float f32x16 __attribute__((ext_vector_type(16)));
typedef short s16x4 __attribute__((ext_vector_type(4)));
__device__ __forceinline__ unsigned cvtpk(float lo, float hi) { return pg8::cvt_pk_bf16(lo, hi); }
__device__ __forceinline__ bf16x8 pack8(float a0, float a1, float a2, float a3, float a4, float a5, float a6, float a7) {
    v4u w; w.x = cvtpk(a0, a1); w.y = cvtpk(a2, a3); w.z = cvtpk(a4, a5); w.w = cvtpk(a6, a7); return __builtin_bit_cast(bf16x8, w); }
__device__ __forceinline__ bf16x8 cat8(v2u lo, v2u hi) { v4u w; w.x = lo.x; w.y = lo.y; w.z = hi.x; w.w = hi.y; return __builtin_bit_cast(bf16x8, w); }

template <bool PAIR>
__device__ __forceinline__ void mini16(const bf16* A16, const bf16* Bt, int K, int n0, int n1, int lane, f32x4& c0, f32x4& c1) {
    const int li = lane & 15, g = lane >> 4;
    const bf16* ap = A16 + (size_t)li * K + 8 * g; const bf16* b0 = Bt + (size_t)(n0 + li) * K + 8 * g; const bf16* b1 = Bt + (size_t)(n1 + li) * K + 8 * g;
    c0 = (f32x4){0.f, 0.f, 0.f, 0.f}; c1 = c0;
    for (int s = 0; s < K / 32; s += 8) {
        bf16x8 a[8], x[8], y[8];
#pragma unroll
        for (int u = 0; u < 8; ++u) { a[u] = *(const GAS bf16x8*)(ap + 32 * (s + u)); x[u] = *(const GAS bf16x8*)(b0 + 32 * (s + u)); if (PAIR) y[u] = *(const GAS bf16x8*)(b1 + 32 * (s + u)); }
#pragma unroll
        for (int u = 0; u < 8; ++u) { c0 = __builtin_amdgcn_mfma_f32_16x16x32_bf16(a[u], x[u], c0, 0, 0, 0); if (PAIR) c1 = __builtin_amdgcn_mfma_f32_16x16x32_bf16(a[u], y[u], c1, 0, 0, 0); }
    }
}
__device__ __forceinline__ void p1_meta(Frame& F) {
    const int gw = F.vcu * NWAVES + F.wave, NGW = F.G * NWAVES, lane = F.lane, li = lane & 15, g = lane >> 4;
    const bf16* A16 = F.XN + (size_t)MSEQ * D;
    constexpr int NPAIR = 2 * RET_H * 8, NBLK = (IN_COLS - 4096) / 16;
    for (int it = gw; it < NPAIR + NBLK; it += NGW) {
        f32x4 c0, c1;
        if (it < NPAIR) {
            const int isk = it >> 6, h = (it >> 3) & 7, i0 = 16 * (it & 7), n0 = isk * 2048 + h * 256 + i0, n1 = n0 + 128;
            mini16<true>(A16, F.WIN, D, n0, n1, lane, c0, c1);
            const float rr = ROPE_REV[i0 + li], lgh = __builtin_log2f(1.0f - __builtin_exp2f(-5.0f - (float)h));
            float o0[4], o1[4];
#pragma unroll
            for (int r = 0; r < 4; ++r) { const int j = 4 * g + r; float t = (float)j * rr; t = t - floorf(t);
                const float sn = __builtin_amdgcn_sinf(t), cs = __builtin_amdgcn_cosf(t), ml = (float)((j + pg8::RPAD) & (pg8::RCH - 1));
                const float sc = isk ? __builtin_exp2f(-ml * lgh) : 0.0625f * __builtin_exp2f(ml * lgh);
                o0[r] = (c0[r] * cs - c1[r] * sn) * sc; o1[r] = (c0[r] * sn + c1[r] * cs) * sc; }
            v2u t0, t1; t0.x = cvtpk(o0[0], o0[1]); t0.y = cvtpk(o0[2], o0[3]); t1.x = cvtpk(o1[0], o1[1]); t1.y = cvtpk(o1[2], o1[3]);
#pragma unroll
            for (int r = 0; r < 4; ++r) { bf16* rp = F.PROJ + (size_t)(MSEQ + 4 * g + r) * IN_COLS + li;
                rp[n0] = (bf16)((r & 1) ? ((r & 2 ? t0.y : t0.x) >> 16) : ((r & 2 ? t0.y : t0.x) & 0xffffu)); rp[n1] = (bf16)((r & 1) ? ((r & 2 ? t1.y : t1.x) >> 16) : ((r & 2 ? t1.y : t1.x) & 0xffffu)); }
            if (isk) {
#pragma unroll
                for (int b = 0; b < NB; ++b) { bf16* kp = F.KST + ((size_t)(b * RET_H + h) * 256 + i0 + li) * pg8::PPR + pg8::RPAD + 4 * g;
                    *(GAS v2u*)kp = t0; *(GAS v2u*)(kp + (size_t)128 * pg8::PPR) = t1; }
            }
        } else {
            const int n0 = 4096 + 16 * (it - NPAIR);
            mini16<false>(A16, F.WIN, D, n0, n0, lane, c0, c1);
            if (n0 >= C_SQ && n0 < C_SK) c0 = c0 * 0.12751743082459868f;
            v2u t0; t0.x = cvtpk(c0[0], c0[1]); t0.y = cvtpk(c0[2], c0[3]);
            if (n0 < C_RG) {
                const int h = (n0 - C_RV) >> 8, d = (n0 & 255) + li;
#pragma unroll
                for (int b = 0; b < NB; ++b) *(GAS v2u*)(F.VT + ((size_t)(b * RET_H + h) * 256 + d) * pg8::PPR + pg8::RPAD + 4 * g) = t0;
            } else if (n0 >= C_SV) {
                const int hd = (n0 - C_SV) >> 7, d = (n0 & 127) + li;
#pragma unroll
                for (int b = 0; b < NB; ++b) *(GAS v2u*)(F.SVT + ((size_t)(b * SB_H + hd) * 128 + d) * pg8::PPS + 4 * g) = t0;
            } else {
#pragma unroll
                for (int r = 0; r < 4; ++r) F.PROJ[(size_t)(MSEQ + 4 * g + r) * IN_COLS + n0 + li] = (bf16)((r & 1) ? ((r & 2 ? t0.y : t0.x) >> 16) : ((r & 2 ? t0.y : t0.x) & 0xffffu));
            }
        }
    }
}
__device__ __forceinline__ void p4_meta(Frame& F) {
    const int gw = F.vcu * NWAVES + F.wave, NGW = F.G * NWAVES, lane = F.lane, li = lane & 15, g = lane >> 4;
    for (int it = gw; it < D / 16; it += NGW) {
        f32x4 c0, c1; const int n0 = 16 * it;
        mini16<false>(F.XN + (size_t)MSEQ * D, F.WOUT, D, n0, n0, lane, c0, c1);
#pragma unroll
        for (int r = 0; r < 4; ++r) F.ABF[(size_t)(MSEQ + 4 * g + r) * D + n0 + li] = (bf16)f2bf(c0[r]);
    }
}

__device__ __forceinline__ size_t pos_row(int b, int p) { return p < NMETA ? (size_t)(MSEQ + p) : (size_t)(b * SEQ + p - NMETA); }

constexpr int RET_NCH = 129, RET_BUF = 49152 + 4096;
__device__ __forceinline__ void ret_dma(Frame& F, LAS unsigned char* L, int b, int h, const bf16* KTg, const bf16* VTg, int c, int bufi) {
    const int lane = F.lane;
#pragma unroll
    for (int i = 0; i < 6; ++i) {
        const int q = F.wave + 8 * i, tile = i >> 1, j = q & 15;
        const bf16* src;
        if (tile < 2) { const int row = 2 * j + (lane >> 5), sc = (lane & 31) ^ (row & 15); int p = 32 * c + row - pg8::RPAD; p = p < 0 ? 0 : p;
            src = F.PROJ + pos_row(b, p) * IN_COLS + (tile ? C_RK : C_RQ) + h * 256 + 8 * sc; }
        else { const int d = 16 * j + (lane >> 2), gq = (lane & 3) ^ ((d >> 2) & 3); src = KTg + (size_t)d * pg8::PPR + 32 * c + 8 * gq; }
        __builtin_amdgcn_global_load_lds((const unsigned*)src, (LAS unsigned*)(L + bufi * RET_BUF + q * 1024), 16, 0, 0);
    }
    if (F.wave < 4)
        __builtin_amdgcn_global_load_lds((const unsigned*)(VTg + (size_t)(lane >> 2) * pg8::PPR + 32 * c + 8 * (lane & 3)), (LAS unsigned*)(L + bufi * RET_BUF + 49152 + F.wave * 1024), 16, 0, 0);
}
__device__ __forceinline__ void ret_group(Frame& F, int grp) {
    const int b = grp >> 5, h = (grp >> 2) & 7, lane = F.lane, li = lane & 15, g = lane >> 4;
    const bool comp = F.wave < 4; const int sl = 4 * (grp & 3) + (F.wave & 3);
    LAS unsigned char* L = F.lds + RING_OFF;
    const bf16* KTg = F.KST + (size_t)(b * RET_H + h) * 256 * pg8::PPR;
    const bf16* VTg = F.VT + ((size_t)(b * RET_H + h) * 256 + sl * 16) * pg8::PPR;
    const float lgh = __builtin_log2f(1.0f - __builtin_exp2f(-5.0f - (float)h)), cdec = __builtin_exp2f(32.0f * lgh);
    f32x4 St[16];
#pragma unroll
    for (int i = 0; i < 16; ++i) St[i] = (f32x4){0.f, 0.f, 0.f, 0.f};
    v2u pend0 = {0u, 0u}, pend1 = {0u, 0u};
    ret_dma(F, L, b, h, KTg, VTg, 0, 0);
    for (int c = 0; c < RET_NCH; ++c) {
        asm volatile("s_waitcnt vmcnt(0)" ::: "memory");
        if (comp && c > 0) {
            const int p0 = 32 * (c - 1) + li - pg8::RPAD, p1 = p0 + 16;
            if (p0 >= NMETA || (p0 >= 0 && b == 0)) *(GAS v2u*)(F.XN + pos_row(b, p0) * D + h * 256 + sl * 16 + 4 * g) = pend0;
            if (p1 >= NMETA || (p1 >= 0 && b == 0)) *(GAS v2u*)(F.XN + pos_row(b, p1) * D + h * 256 + sl * 16 + 4 * g) = pend1;
        }
        asm volatile("" ::: "memory"); __builtin_amdgcn_s_barrier(); asm volatile("" ::: "memory");
        if (c + 1 < RET_NCH) ret_dma(F, L, b, h, KTg, VTg, c + 1, (c + 1) & 1);
        if (comp) {
            const LAS unsigned char* base = L + (c & 1) * RET_BUF;
            const LAS unsigned char* vb = base + 49152 + F.wave * 1024 + li * 64;
            const v2u vfa = *(const LAS v2u*)(vb + 8 * g), vfb = *(const LAS v2u*)(vb + 32 + 8 * g); const bf16x8 Vn = *(const LAS bf16x8*)(vb + 16 * g);
            f32x4 ST0 = {0.f, 0.f, 0.f, 0.f}, ST1 = ST0, ST2 = ST0, OT0 = ST0, OT1 = ST0;
#pragma unroll
            for (int s = 0; s < 8; ++s) {
                bf16x8 Qf[2], Kf[2];
#pragma unroll
                for (int k = 0; k < 2; ++k) { const int row = 16 * k + li;
                    const int a0 = (row * 32 + ((4 * s + (g >> 1)) ^ li)) * 16 + 8 * (g & 1), a1 = (row * 32 + ((4 * s + 2 + (g >> 1)) ^ li)) * 16 + 8 * (g & 1);
                    Qf[k] = cat8(*(const LAS v2u*)(base + a0), *(const LAS v2u*)(base + a1));
                    Kf[k] = cat8(*(const LAS v2u*)(base + 16384 + a0), *(const LAS v2u*)(base + 16384 + a1)); }
                const bf16x8 SA = pack8(St[2 * s][0], St[2 * s][1], St[2 * s][2], St[2 * s][3], St[2 * s + 1][0], St[2 * s + 1][1], St[2 * s + 1][2], St[2 * s + 1][3]);
                ST0 = __builtin_amdgcn_mfma_f32_16x16x32_bf16(Kf[0], Qf[0], ST0, 0, 0, 0);
                ST1 = __builtin_amdgcn_mfma_f32_16x16x32_bf16(Kf[0], Qf[1], ST1, 0, 0, 0);
                ST2 = __builtin_amdgcn_mfma_f32_16x16x32_bf16(Kf[1], Qf[1], ST2, 0, 0, 0);
                OT0 = __builtin_amdgcn_mfma_f32_16x16x32_bf16(SA, Qf[0], OT0, 0, 0, 0);
                OT1 = __builtin_amdgcn_mfma_f32_16x16x32_bf16(SA, Qf[1], OT1, 0, 0, 0);
            }
#pragma unroll
            for (int r = 0; r < 4; ++r) if (4 * g + r > li) { ST0[r] = 0.f; ST2[r] = 0.f; }
            const bf16x8 Vf = cat8(vfa, vfb);
            OT0 = __builtin_amdgcn_mfma_f32_16x16x32_bf16(Vf, pack8(ST0[0], ST0[1], ST0[2], ST0[3], 0.f, 0.f, 0.f, 0.f), OT0, 0, 0, 0);
            OT1 = __builtin_amdgcn_mfma_f32_16x16x32_bf16(Vf, pack8(ST1[0], ST1[1], ST1[2], ST1[3], ST2[0], ST2[1], ST2[2], ST2[3]), OT1, 0, 0, 0);
            pend0.x = cvtpk(OT0[0], OT0[1]); pend0.y = cvtpk(OT0[2], OT0[3]); pend1.x = cvtpk(OT1[0], OT1[1]); pend1.y = cvtpk(OT1[2], OT1[3]);
#pragma unroll
            for (int db = 0; db < 16; ++db) { const int d = 16 * db + li;
                const bf16x8 Kt = *(const LAS bf16x8*)(base + 32768 + (d * 4 + (g ^ ((d >> 2) & 3))) * 16);
                St[db] = __builtin_amdgcn_mfma_f32_16x16x32_bf16(Kt, Vn, St[db], 0, 0, 0);
                St[db] = St[db] * cdec; }
        }
    }
    if (comp) {
        const int p0 = 32 * (RET_NCH - 1) + li - pg8::RPAD, p1 = p0 + 16;
        *(GAS v2u*)(F.XN + pos_row(b, p0) * D + h * 256 + sl * 16 + 4 * g) = pend0;
        *(GAS v2u*)(F.XN + pos_row(b, p1) * D + h * 256 + sl * 16 + 4 * g) = pend1;
    }
    asm volatile("s_waitcnt vmcnt(0)" ::: "memory"); __builtin_amdgcn_s_barrier();
}

__device__ __forceinline__ void sb_unit(Frame& F, int b, int hd, int i) {
    const int lane = F.lane, r32 = lane & 31, hh = lane >> 5;
    const int pq = 32 * i + r32; const bool qvalid = pq < SEQ + NMETA;
    const bf16* qrow = F.PROJ + pos_row(b, qvalid ? pq : SEQ + NMETA - 1) * IN_COLS + C_SQ + hd * 128 + 8 * hh;
    bf16x8 qf[8];
#pragma unroll
    for (int kk = 0; kk < 8; ++kk) qf[kk] = *(const GAS bf16x8*)(qrow + 16 * kk);
    f32x16 o[4];
#pragma unroll
    for (int c = 0; c < 4; ++c)
#pragma unroll
        for (int r = 0; r < 16; ++r) o[c][r] = 0.f;
    float R = 0.f;
    const bf16* svt = F.SVT + ((size_t)(b * SB_H + hd) * 128 + r32) * pg8::PPS + 8 * hh;
    const int kperm = (r32 & ~12) | ((r32 & 4) << 1) | ((r32 & 8) >> 1);
    for (int kb = i; kb >= 0; --kb) {
        const int pk = 32 * kb + kperm;
        const bf16* krow = F.PROJ + pos_row(b, pk < SEQ + NMETA ? pk : SEQ + NMETA - 1) * IN_COLS + C_SK + hd * 128 + 8 * hh;
        bf16x8 kf[8], vf[8];
#pragma unroll
        for (int kk = 0; kk < 8; ++kk) kf[kk] = *(const GAS bf16x8*)(krow + 16 * kk);
#pragma unroll
        for (int c = 0; c < 4; ++c)
#pragma unroll
            for (int ks = 0; ks < 2; ++ks) vf[c * 2 + ks] = *(const GAS bf16x8*)(svt + (size_t)(32 * c) * pg8::PPS + 32 * kb + 16 * ks);
        f32x16 sacc;
#pragma unroll
        for (int r = 0; r < 16; ++r) sacc[r] = 0.f;
#pragma unroll
        for (int kk = 0; kk < 8; ++kk) sacc = __builtin_amdgcn_mfma_f32_32x32x16_bf16(kf[kk], qf[kk], sacc, 0, 0, 0);
        float lk[16], zb[16]; bool vm[16];
#pragma unroll
        for (int r = 0; r < 16; ++r) {
            const float z = sacc[r];
            const float sp = fmaxf(z, 0.f) + __builtin_amdgcn_logf(1.0f + __builtin_amdgcn_exp2f(-fabsf(z)));
            vm[r] = (kb < i) || (16 * (r >> 3) + 8 * hh + (r & 7) < r32);
            lk[r] = vm[r] ? -sp : 0.f; zb[r] = z - sp;
        }
        float ghi = 0.f, glo = 0.f;
#pragma unroll
        for (int r = 0; r < 8; ++r) { glo += lk[r]; ghi += lk[8 + r]; }
        const float pghi = __shfl_xor(ghi, 32), pglo = __shfl_xor(glo, 32);
        const float Thi = ghi + pghi, Tlo = glo + pglo;
        float w[16];
        float run = R + (hh ? 0.f : pghi);
#pragma unroll
        for (int r = 15; r >= 8; --r) { w[r] = vm[r] ? __builtin_amdgcn_exp2f(zb[r] + run) : 0.f; run += lk[r]; }
        run = (R + Thi) + (hh ? 0.f : pglo);
#pragma unroll
        for (int r = 7; r >= 0; --r) { w[r] = vm[r] ? __builtin_amdgcn_exp2f(zb[r] + run) : 0.f; run += lk[r]; }
        R = (R + Thi) + Tlo;
        const bf16x8 pa0 = pack8(w[0], w[1], w[2], w[3], w[4], w[5], w[6], w[7]), pa1 = pack8(w[8], w[9], w[10], w[11], w[12], w[13], w[14], w[15]);
#pragma unroll
        for (int c = 0; c < 4; ++c) {
            o[c] = __builtin_amdgcn_mfma_f32_32x32x16_bf16(vf[c * 2 + 0], pa0, o[c], 0, 0, 0);
            o[c] = __builtin_amdgcn_mfma_f32_32x32x16_bf16(vf[c * 2 + 1], pa1, o[c], 0, 0, 0);
        }
        if (__all((R < -160.f) || !qvalid)) break;
    }
    float ss = 0.f;
#pragma unroll
    for (int c = 0; c < 4; ++c)
#pragma unroll
        for (int r = 0; r < 16; ++r) ss += o[c][r] * o[c][r];
    ss += __shfl_xor(ss, 32);
    const float rinv = 1.0f / sqrtf(ss * (1.f / 128.f) + EPS);
    {
        const float* wv = F.sbn_w + hd * 128 + 4 * hh;
        f32x4 wn[16];
#pragma unroll
        for (int k = 0; k < 16; ++k) wn[k] = *(const GAS f32x4*)(wv + 32 * (k >> 2) + 8 * (k & 3));
        if (qvalid && (b == 0 || pq >= NMETA)) {
            bf16* orow = F.XN + pos_row(b, pq) * D + 2048 + hd * 128 + 4 * hh;
#pragma unroll
            for (int c = 0; c < 4; ++c)
#pragma unroll
                for (int q4 = 0; q4 < 4; ++q4) {
                    const f32x4 w4 = wn[c * 4 + q4];
                    v2u ov; ov.x = cvtpk(o[c][4 * q4] * rinv * w4.x, o[c][4 * q4 + 1] * rinv * w4.y); ov.y = cvtpk(o[c][4 * q4 + 2] * rinv * w4.z, o[c][4 * q4 + 3] * rinv * w4.w);
                    *(GAS v2u*)(orow + 32 * c + 8 * q4) = ov;
                }
        }
    }
}

__device__ __forceinline__ void p2_mixers(Frame& F) {
    constexpr int NGRP = NB * RET_H * 4;
    constexpr int NSLAB = (SEQ + NMETA + 31) / 32;
    if (F.vcu < NGRP) ret_group(F, F.vcu);
    else for (int it = (F.vcu - NGRP) * NWAVES + F.wave; it < NB * SB_H * NSLAB; it += (F.G - NGRP) * NWAVES) { const int bh = it / NSLAB, sl = it % NSLAB; sb_unit(F, bh >> 4, bh & 15, sl); }
}

__device__ __forceinline__ void p3_retnorm(Frame& F) {
    const int gw = F.vcu * NWAVES + F.wave, NGW = F.G * NWAVES, lane = F.lane;
    for (int item = gw; item < RET_H * MROWS; item += NGW) {
        const int h = item & 7, rr = item >> 3;
        GAS v2u* yp = (GAS v2u*)(F.XN + (size_t)rr * D + h * 256 + 4 * lane);
        const v2u yv = *yp; const float o0 = bflo(yv.x), o1 = bfhi(yv.x), o2 = bflo(yv.y), o3 = bfhi(yv.y);
        const float ss = wave_sum(o0 * o0 + o1 * o1 + o2 * o2 + o3 * o3);
        const float r = 1.0f / sqrtf(ss * (1.f / 256.f) + EPS);
        const f32x4 gw4 = *(const GAS f32x4*)(F.gn_w + h * 256 + 4 * lane);
        const v2u gv = *(const GAS v2u*)(F.PROJ + (size_t)rr * IN_COLS + C_RG + h * 256 + 4 * lane);
        const float g0 = bflo(gv.x), g1 = bfhi(gv.x), g2 = bflo(gv.y), g3 = bfhi(gv.y);
        const float y0 = g0 / (1.f + __expf(-g0)) * (o0 * r * gw4.x), y1 = g1 / (1.f + __expf(-g1)) * (o1 * r * gw4.y);
        const float y2 = g2 / (1.f + __expf(-g2)) * (o2 * r * gw4.z), y3 = g3 / (1.f + __expf(-g3)) * (o3 * r * gw4.w);
        v2u ov; ov.x = pk2(y0, y1); ov.y = pk2(y2, y3); *yp = ov;
    }
}

__device__ __forceinline__ void p4_norms(Frame& F) {
    const int gw = F.vcu * NWAVES + F.wave, NGW = F.G * NWAVES;
    for (int m = gw; m < MROWS; m += NGW) {
        const GAS v2u* ab = (const GAS v2u*)(F.ABF + (size_t)m * D) + F.lane;
        GAS f32x4* h2 = (GAS f32x4*)(m < MSEQ ? F.out + (size_t)m * D : F.META + (size_t)(m - MSEQ) * D) + F.lane;
        const GAS f32x4* hr = (const GAS f32x4*)h_row(F, m) + F.lane;
        const GAS f32x4* wp = (const GAS f32x4*)F.w_post + F.lane; const GAS f32x4* wq = (const GAS f32x4*)F.w_pre2 + F.lane;
        f32x4 v[16]; float s = 0.f;
#pragma unroll
        for (int j = 0; j < 16; ++j) { const v2u a2 = ab[64 * j]; v[j] = (f32x4){bflo(a2.x), bfhi(a2.x), bflo(a2.y), bfhi(a2.y)}; s += (v[j].x * v[j].x + v[j].y * v[j].y) + (v[j].z * v[j].z + v[j].w * v[j].w); }
        const float r = 1.0f / sqrtf(wave_sum(s) * (1.f / D) + EPS); float s2 = 0.f;
#pragma unroll
        for (int j = 0; j < 16; ++j) { const f32x4 w = wp[64 * j], hv = hr[64 * j]; v[j] = hv + v[j] * r * w; h2[64 * j] = v[j]; s2 += (v[j].x * v[j].x + v[j].y * v[j].y) + (v[j].z * v[j].z + v[j].w * v[j].w); }
        const float r2 = 1.0f / sqrtf(wave_sum(s2) * (1.f / D) + EPS);
        GAS v2u* o8 = (GAS v2u*)(F.XN + (size_t)m * D) + F.lane;
#pragma unroll
        for (int j = 0; j < 16; ++j) { const f32x4 w = wq[64 * j]; v2u o; o.x = pk2(v[j].x * r2 * w.x, v[j].y * r2 * w.y); o.y = pk2(v[j].z * r2 * w.z, v[j].w * r2 * w.w); o8[64 * j] = o; }
    }
}

__device__ __forceinline__ void p6_fixup(Frame& F) {
    const int gt = F.vcu * (NWAVES * 64) + F.tid, NGT = F.G * NWAVES * 64;
    constexpr int QC = DFF / 4;
    for (int i = gt; i < 256 * QC; i += NGT) {
        const int sg = i / QC, jq = i % QC, j = 4 * jq;
        const int prev = (sg & 63) == 0 ? 256 : sg - 1;
        const f32x4 h0 = *(const GAS f32x4*)(F.HALO + ((size_t)prev * 2 + 0) * DFF + j), h1 = *(const GAS f32x4*)(F.HALO + ((size_t)prev * 2 + 1) * DFF + j);
        const f32x4 g0 = *(const GAS f32x4*)(F.FIRSTG + ((size_t)sg * 2 + 0) * DFF + j), g1 = *(const GAS f32x4*)(F.FIRSTG + ((size_t)sg * 2 + 1) * DFF + j);
        const f32x4 u0 = *(const GAS f32x4*)(F.FIRSTU + ((size_t)sg * 2 + 0) * DFF + j), u1 = *(const GAS f32x4*)(F.FIRSTU + ((size_t)sg * 2 + 1) * DFF + j);
        const f32x4 w0 = *(const GAS f32x4*)(F.conv_w + j), w1 = *(const GAS f32x4*)(F.conv_w + DFF + j), w2 = *(const GAS f32x4*)(F.conv_w + 2 * DFF + j), bb = *(const GAS f32x4*)(F.conv_b + j);
        float a0[4], a1[4];
#pragma unroll
        for (int e = 0; e < 4; ++e) {
            const float c0 = bb[e] + w0[e] * h0[e] + w1[e] * h1[e] + w2[e] * g0[e];
            const float c1 = bb[e] + w0[e] * h1[e] + w1[e] * g0[e] + w2[e] * g1[e];
            a0[e] = c0 / (1.f + __expf(-c0)) * u0[e]; a1[e] = c1 / (1.f + __expf(-c1)) * u1[e];
        }
        v2u o; o.x = pk2(a0[0], a0[1]); o.y = pk2(a0[2], a0[3]); *(GAS v2u*)(F.ACT + (size_t)(sg * 64) * DFF + j) = o;
        o.x = pk2(a1[0], a1[1]); o.y = pk2(a1[2], a1[3]); *(GAS v2u*)(F.ACT + (size_t)(sg * 64 + 1) * DFF + j) = o;
    }
}

__device__ __forceinline__ void p8_final(Frame& F) {
    const int gw = F.vcu * NWAVES + F.wave, NGW = F.G * NWAVES;
    for (int m = gw; m < MSEQ; m += NGW) {
        GAS f32x4* orow = (GAS f32x4*)(F.out + (size_t)m * D) + F.lane; const GAS v2u* fr = (const GAS v2u*)(F.Fb + (size_t)m * D) + F.lane;
        const GAS f32x4* wp = (const GAS f32x4*)F.w_post2 + F.lane;
        f32x4 v[16], hv[16]; float s = 0.f;
#pragma unroll
        for (int j = 0; j < 16; ++j) { const v2u a2 = fr[64 * j]; hv[j] = orow[64 * j]; v[j] = (f32x4){bflo(a2.x), bfhi(a2.x), bflo(a2.y), bfhi(a2.y)}; s += (v[j].x * v[j].x + v[j].y * v[j].y) + (v[j].z * v[j].z + v[j].w * v[j].w); }
        const float r = 1.0f / sqrtf(wave_sum(s) * (1.f / D) + EPS);
#pragma unroll
        for (int j = 0; j < 16; ++j) { const f32x4 w = wp[64 * j]; orow[64 * j] = hv[j] + v[j] * r * w; }
    }
}

struct Args { const float* in[14]; float* out; unsigned char* ws; int ph_lo, ph_hi; };
__global__ void __launch_bounds__(NWAVES * 64, 2) hymba_fwd(Args args) {
    extern __shared__ __attribute__((aligned(16))) unsigned char lds[];
    Frame F;
    F.lds = (LAS unsigned char*)lds;
    F.MISC = (volatile LAS unsigned*)(F.lds + MISC_OFF);
    F.tid = threadIdx.x; F.lane = F.tid & 63; F.wave = __builtin_amdgcn_readfirstlane(F.tid >> 6);
    F.G = gridDim.x; { const int bx = blockIdx.x; F.vcu = (F.G % 8 == 0) ? (bx % 8) * (F.G / 8) + bx / 8 : bx; }
    unsigned char* ws = args.ws;
    F.ctl = (gu32*)(ws + WS_CTL);
    F.x = args.in[0]; F.meta = args.in[1]; F.w_pre = args.in[2]; F.w_in = args.in[3]; F.gn_w = args.in[4]; F.sbn_w = args.in[5]; F.w_out = args.in[6]; F.w_post = args.in[7];
    F.w_pre2 = args.in[8]; F.w_up = args.in[9]; F.conv_w = args.in[10]; F.conv_b = args.in[11]; F.w_down = args.in[12]; F.w_post2 = args.in[13]; F.out = args.out;
    F.WIN = (bf16*)(ws + WS_WIN); F.WOUT = (bf16*)(ws + WS_WOUT); F.WUP = (bf16*)(ws + WS_WUP); F.WDOWN = (bf16*)(ws + WS_WDOWN); F.XN = (bf16*)(ws + WS_XN);
    F.PROJ = (bf16*)(ws + WS_PROJ); F.ACT = (bf16*)(ws + WS_ACT); F.META = (float*)(ws + WS_META); F.HALO = (float*)(ws + WS_HALO); F.FIRSTG = (float*)(ws + WS_FIRSTG);
    F.FIRSTU = (float*)(ws + WS_FIRSTU); F.Fb = (bf16*)(ws + WS_F); F.ABF = (bf16*)(ws + WS_ABF); F.KST = (bf16*)(ws + WS_KST); F.VT = (bf16*)(ws + WS_VT); F.SVT = (bf16*)(ws + WS_SVT);
    for (int u = F.tid; u < (LDS_BYTES - LDSCTL_OFF) / 4; u += NWAVES * 64) ((LAS unsigned*)(F.lds + LDSCTL_OFF))[u] = 0u;
    __syncthreads();
    XcdBarrier bar; bar.bar = (unsigned*)(F.ctl + CW_BAR); bar.x = 0; bar.st = nullptr;
    if (N_LAUNCHES == 1) bar = xcd_barrier_post((unsigned*)(F.ctl + CW_BAR), F.MISC + 8);
#define GRID_BAR() do { if (N_LAUNCHES == 1) xcd_barrier(bar); } while (0)
    const int lo = args.ph_lo, hi = args.ph_hi;
#define IN(k) (lo <= (k) && (k) < hi)
#define BOTH(k) (IN(k) && IN((k) + 1))

    if (IN(0)) for (int rep_ = 0; rep_ <= DUP(0); ++rep_) { p0_prologue(F); if (BOTH(0)) GRID_BAR(); }
    if (IN(1)) for (int rep_ = 0; rep_ <= DUP(1); ++rep_) {
        pg8::Gemm g{F.XN, F.WIN, MSEQ, IN_COLS, D}; pg8::StaticOrder S; S.init(MSEQ, IN_COLS, F.G, (int)blockIdx.x);
        pg8::EpiProj E{F.PROJ, IN_COLS, ROPE_REV, F.KST, F.VT, F.SVT, F.lds + TS_OFF};
        pg8::gemm_phase<pg8::EpiProj, pg8::StaticOrder, PG8_ALIGN, PG8_SP2>(F.lds + RING_OFF, g, S, E);
        p1_meta(F);
        if (BOTH(1)) GRID_BAR();
    }
    if (IN(2)) for (int rep_ = 0; rep_ <= DUP(2); ++rep_) { p2_mixers(F); if (BOTH(2)) GRID_BAR(); }
    if (IN(3)) { p3_retnorm(F); if (BOTH(3)) GRID_BAR(); }
    if (IN(4)) for (int rep_ = 0; rep_ <= DUP(4); ++rep_) {
        pg8::Gemm g{F.XN, F.WOUT, MSEQ, D, D}; pg8::StaticOrder S; S.init(MSEQ, D, F.G, (int)blockIdx.x);
        pg8::EpiBf16Plain E{F.ABF, D};
        pg8::gemm_phase<pg8::EpiBf16Plain, pg8::StaticOrder, PG8_ALIGN, PG8_SP2>(F.lds + RING_OFF, g, S, E);
        p4_meta(F);
        if (BOTH(4)) GRID_BAR();
    }
    if (IN(5)) { p4_norms(F); if (BOTH(5)) GRID_BAR(); }
    if (IN(6)) for (int rep_ = 0; rep_ <= DUP(6); ++rep_) {
        pg8::Gemm g{F.XN, F.WUP, MPAD, NUP, D}; pg8::StaticOrder S; S.init(MPAD, NUP, F.G, (int)blockIdx.x);
        pg8::EpiConv E{F.ACT, F.HALO, F.FIRSTG, F.FIRSTU, F.conv_w, F.conv_b, DFF};
        pg8::gemm_phase<pg8::EpiConv, pg8::StaticOrder, PG8_ALIGN, PG8_SP2>(F.lds + RING_OFF, g, S, E);
        if (BOTH(6)) GRID_BAR();
    }
    if (IN(7)) { p6_fixup(F); if (BOTH(7)) GRID_BAR(); }
    if (IN(8)) for (int rep_ = 0; rep_ <= DUP(8); ++rep_) {
        pg8::Gemm g{F.ACT, F.WDOWN, MSEQ, D, DFF}; pg8::StaticOrder S; S.init(MSEQ, D, F.G, (int)blockIdx.x);
        pg8::EpiBf16Plain E{F.Fb, D};
        pg8::gemm_phase<pg8::EpiBf16Plain, pg8::StaticOrder, PG8_ALIGN, PG8_SP2>(F.lds + RING_OFF, g, S, E);
        if (BOTH(8)) GRID_BAR();
    }
    if (IN(9)) { p8_final(F); }
#undef IN
#undef BOTH
}

extern "C" void kernel_launch(void* const* d_in, const int* in_sizes, int n_in, void* d_out, int out_size, void* d_ws, size_t ws_size, hipStream_t stream) {
    static int grid = 0;
    if (grid == 0) {
        if (n_in != 14 || out_size != MSEQ * D || ws_size < WS_END) { fprintf(stderr, "kernel_launch: unexpected shapes (n_in %d, out %d, ws %zu < %zu)\n", n_in, out_size, ws_size, (size_t)WS_END); grid = -1; return; }
        int dev = 0, cus = 0, per_cu = 0;
        if (hipGetDevice(&dev) != hipSuccess || hipDeviceGetAttribute(&cus, hipDeviceAttributeMultiprocessorCount, dev) != hipSuccess) { grid = -1; return; }
        if (hipFuncSetAttribute((const void*)hymba_fwd, hipFuncAttributeMaxDynamicSharedMemorySize, LDS_BYTES) != hipSuccess) { fprintf(stderr, "kernel_launch: hipFuncSetAttribute failed\n"); grid = -1; return; }
        if (hipOccupancyMaxActiveBlocksPerMultiprocessor(&per_cu, (const void*)hymba_fwd, NWAVES * 64, LDS_BYTES) != hipSuccess || per_cu < 1) fprintf(stderr, "kernel_launch: occupancy query reports %d\n", per_cu);
        (void)hipGetLastError();
        grid = cus;
    }
    if (grid < 0) return;
    if (hipMemsetAsync((char*)d_ws + WS_CTL, 0, CTL_ZERO_BYTES, stream) != hipSuccess) return;
    Args a{};
    for (int i = 0; i < 14; ++i) a.in[i] = (const float*)d_in[i];
    a.out = (float*)d_out; a.ws = (unsigned char*)d_ws;
    if (N_LAUNCHES == 1) { a.ph_lo = 0; a.ph_hi = N_PHASES; hipLaunchKernelGGL(hymba_fwd, dim3(grid), dim3(NWAVES * 64), LDS_BYTES, stream, a); }
    else for (int p = 0; p < N_PHASES; ++p) { a.ph_lo = p; a.ph_hi = p + 1; hipLaunchKernelGGL(hymba_fwd, dim3(grid), dim3(NWAVES * 64), LDS_BYTES, stream, a); }
    const hipError_t le = hipPeekAtLastError();
    if (le != hipSuccess) fprintf(stderr, "kernel_launch: launch failed: %s\n", hipGetErrorName(le));
}
```
